# Optimizing an MI355X kernel written in HIP

```python
import jax, jax.numpy as jnp
from jax import lax
import numpy as np

D_MODEL = 1024
BATCH = 4
SEQ = 4096
DEPTH = 4
DEC_BATCH = 8
DEC_SEQ = 64
PAST_LEN = 4096

CHUNK = 64
N_EVEN = (DEPTH + 1) // 2
N_ODD = DEPTH // 2
EPS = 1e-6
NEG_INF = -1e30
CONV_DIM = D_MODEL // 2
CONV_WIDTH = 3
GLA_HEADS = 4
GLA_DV = D_MODEL // 2
GLA_DK = GLA_DV // 2
GLA_HEAD_V = GLA_DV // GLA_HEADS
GLA_HEAD_K = GLA_DK // GLA_HEADS
GATE_RANK = 16
GATE_NORM = 16.0
MIX_AB = CONV_DIM + GLA_DV
IN_SIZES = (CONV_DIM, CONV_DIM, CONV_DIM, GLA_DK, GLA_DK, GLA_DV, GLA_DV, GATE_RANK)
IN_AB = sum(IN_SIZES)
ATT_HEADS = 16
ATT_HEAD_DIM = 64
ATT_DIM = ATT_HEADS * ATT_HEAD_DIM
N_PREV_CHUNKS = 8
BAND_ROWS = N_PREV_CHUNKS * CHUNK
MAX_REL = 256
REL_SIZE = MAX_REL + CHUNK
D_FF = ((8 * D_MODEL // 3 + 255) // 256) * 256

kernel_name = "hybrid_streaming_conv_gla_chunkattn_step"


def rms_norm(x, g):
    xf = x.astype(jnp.float32)
    y = xf * lax.rsqrt(jnp.mean(xf * xf, axis=-1, keepdims=True) + EPS)
    return (y * g.astype(jnp.float32)).astype(x.dtype)


def short_conv_mixer(c_gate, b_gate, h, conv_w, prev):
    T = h.shape[1]
    u = c_gate * h
    up = jnp.concatenate([prev.astype(u.dtype), u], axis=1)
    y = sum(conv_w[i] * up[:, i:i + T] for i in range(CONV_WIDTH))
    return b_gate * y, up[:, T:]


def gla_scan(q, k, v, log_a, s0):
    B, T, H, DK = q.shape
    DV = v.shape[-1]
    L = min(T, CHUNK)
    n = T // L

    def blocks(a):
        return a.reshape(B, n, L, H, a.shape[-1]).swapaxes(0, 1)

    causal = jnp.tril(jnp.ones((L, L), dtype=bool))

    def step(S, blk):
        qc, kc, vc, gc = blk
        b = jnp.cumsum(gc, axis=1)
        b_last = b[:, -1]
        q_e = qc * jnp.exp(b)
        k_e = kc * jnp.exp(-b)
        att = jnp.where(causal, jnp.einsum('bihd,bjhd->bhij', q_e, k_e), 0.0)
        o = jnp.einsum('bhij,bjhv->bihv', att, vc) + jnp.einsum('bihd,bhdv->bihv', q_e, S)
        k_dec = kc * jnp.exp(b_last[:, None] - b)
        S = jnp.exp(b_last)[..., None] * S + jnp.einsum('bjhd,bjhv->bhdv', k_dec, vc)
        return S, o

    S, o = lax.scan(step, s0.astype(jnp.float32), (blocks(q), blocks(k), blocks(v), blocks(log_a)))
    return o.swapaxes(0, 1).reshape(B, T, H, DV), S


def gla_mixer(q, k, v, g, gk_low, gk_w2, gk_b, onorm, s0):
    B, T, _ = q.shape
    f32 = jnp.float32
    shp_k = (B, T, GLA_HEADS, GLA_HEAD_K)
    shp_v = (B, T, GLA_HEADS, GLA_HEAD_V)
    qh = q.astype(f32).reshape(shp_k) * GLA_HEAD_K ** -0.5
    kh = k.astype(f32).reshape(shp_k)
    vh = v.astype(f32).reshape(shp_v)
    log_a = jax.nn.log_sigmoid((gk_low @ gk_w2 + gk_b).astype(f32)).reshape(shp_k) / GATE_NORM
    o, s_new = gla_scan(qh, kh, vh, log_a, s0)
    o = rms_norm(o, onorm) * jax.nn.silu(g.astype(f32)).reshape(shp_v)
    return o.reshape(B, T, GLA_DV).astype(q.dtype), s_new


def band_attention(q, k, v, k_hist, v_hist, pos0, rel_bias):
    B, T, H, Dh = q.shape
    W = k_hist.shape[1]
    L = min(T, CHUNK)
    n = T // L
    k_all = jnp.concatenate([k_hist.astype(k.dtype), k], axis=1)
    v_all = jnp.concatenate([v_hist.astype(v.dtype), v], axis=1)
    scale = Dh ** -0.5

    def one_block(c):
        start = c * L
        qc = lax.dynamic_slice_in_dim(q, start, L, axis=1)
        kc = lax.dynamic_slice_in_dim(k_all, start, W + L, axis=1)
        vc = lax.dynamic_slice_in_dim(v_all, start, W + L, axis=1)
        q_pos = pos0 + start + jnp.arange(L)
        k_pos = pos0 - W + start + jnp.arange(W + L)
        q_chunk = q_pos[:, None] // CHUNK
        k_chunk = k_pos[None, :] // CHUNK
        allowed = (k_pos[None, :] >= 0) & (k_chunk <= q_chunk) & (k_chunk >= q_chunk - N_PREV_CHUNKS)
        rel = jnp.clip(q_pos[:, None] - k_pos[None, :], -(CHUNK - 1), MAX_REL) + (CHUNK - 1)
        bias = rel_bias[:, rel].astype(jnp.float32)
        s = jnp.einsum('bqhd,bkhd->bhqk', qc, kc).astype(jnp.float32) * scale + bias
        p = jax.nn.softmax(jnp.where(allowed, s, NEG_INF), axis=-1).astype(vc.dtype)
        return jnp.einsum('bhqk,bkhd->bqhd', p, vc)

    out = lax.map(one_block, jnp.arange(n))
    return out.swapaxes(0, 1).reshape(B, T, H, Dh)


def swiglu_ffn(h, w_in, w_out):
    gate, up = jnp.split(h @ w_in, 2, axis=-1)
    return (jax.nn.silu(gate) * up) @ w_out


def trunk(x, pos0, keep_rows, conv_prev, gla_prev, k_hist, v_hist,
          norm_mix, norm_ffn, w_in_ab, conv_w, gla_gk_w2, gla_gk_b, gla_onorm, w_out_ab,
          w_qkv, q_norm, k_norm, rel_bias, w_o_att, w_ffn_in, w_ffn_out):
    B, T, _ = x.shape
    split_at = [int(s) for s in np.cumsum(IN_SIZES)[:-1]]
    conv_new, gla_new, k_new, v_new = [], [], [], []
    for layer in range(DEPTH):
        h = rms_norm(x, norm_mix[layer])
        if layer % 2 == 0:
            e = layer // 2
            c_g, b_g, hc, q, k, v, g, gk_low = jnp.split(h @ w_in_ab[e], split_at, axis=-1)
            ya, cs = short_conv_mixer(c_g, b_g, hc, conv_w[e], conv_prev[e])
            yb, ss = gla_mixer(q, k, v, g, gk_low, gla_gk_w2[e], gla_gk_b[e], gla_onorm[e], gla_prev[e])
            x = x + jnp.concatenate([ya, yb], axis=-1) @ w_out_ab[e]
            conv_new.append(cs)
            gla_new.append(ss)
        else:
            o = layer // 2
            qkv = (h @ w_qkv[o]).reshape(B, T, 3, ATT_HEADS, ATT_HEAD_DIM)
            q = rms_norm(qkv[:, :, 0], q_norm[o])
            k = rms_norm(qkv[:, :, 1], k_norm[o])
            v = qkv[:, :, 2]
            att = band_attention(q, k, v, k_hist[o], v_hist[o], pos0, rel_bias[o])
            x = x + att.reshape(B, T, ATT_DIM) @ w_o_att[o]
            k_new.append(jnp.concatenate([k_hist[o].astype(k.dtype), k], axis=1)[:, -keep_rows:])
            v_new.append(jnp.concatenate([v_hist[o].astype(v.dtype), v], axis=1)[:, -keep_rows:])
        x = x + swiglu_ffn(rms_norm(x, norm_ffn[layer]), w_ffn_in[layer], w_ffn_out[layer])
    return x, jnp.stack(conv_new), jnp.stack(gla_new), jnp.stack(k_new), jnp.stack(v_new)


def setup_inputs(seed: int = 0) -> dict:
    key = jax.random.key(seed)
    ks = jax.random.split(key, 24)

    def nrm(k, shape, scale):
        return jax.random.normal(k, shape, jnp.float32) * scale

    win_rows = min(BAND_ROWS, PAST_LEN)
    return {
        "x_prompt": nrm(ks[0], (BATCH, SEQ, D_MODEL), 1.0),
        "x_sample": nrm(ks[1], (DEC_BATCH, DEC_SEQ, D_MODEL), 1.0),
        "state_conv": nrm(ks[2], (N_EVEN, DEC_BATCH, CONV_WIDTH - 1, CONV_DIM), 1.0),
        "state_gla": nrm(ks[3], (N_EVEN, DEC_BATCH, GLA_HEADS, GLA_HEAD_K, GLA_HEAD_V), 0.5),
        "cache_k": nrm(ks[4], (N_ODD, DEC_BATCH, win_rows, ATT_HEADS, ATT_HEAD_DIM), 1.0),
        "cache_v": nrm(ks[5], (N_ODD, DEC_BATCH, win_rows, ATT_HEADS, ATT_HEAD_DIM), 1.0),
        "norm_mix": 1.0 + nrm(ks[6], (DEPTH, D_MODEL), 0.02),
        "norm_ffn": 1.0 + nrm(ks[7], (DEPTH, D_MODEL), 0.02),
        "w_in_ab": nrm(ks[8], (N_EVEN, D_MODEL, IN_AB), D_MODEL ** -0.5),
        "conv_w": nrm(ks[9], (N_EVEN, CONV_WIDTH, CONV_DIM), CONV_WIDTH ** -0.5),
        "gla_gk_w2": nrm(ks[10], (N_EVEN, GATE_RANK, GLA_DK), GATE_RANK ** -0.5),
        "gla_gk_b": nrm(ks[11], (N_EVEN, GLA_DK), 0.1),
        "gla_onorm": 1.0 + nrm(ks[12], (N_EVEN, GLA_HEAD_V), 0.02),
        "w_out_ab": nrm(ks[13], (N_EVEN, MIX_AB, D_MODEL), MIX_AB ** -0.5),
        "w_qkv": nrm(ks[14], (N_ODD, D_MODEL, 3 * ATT_DIM), D_MODEL ** -0.5),
        "q_norm": 1.0 + nrm(ks[15], (N_ODD, ATT_HEAD_DIM), 0.02),
        "k_norm": 1.0 + nrm(ks[16], (N_ODD, ATT_HEAD_DIM), 0.02),
        "rel_bias": nrm(ks[17], (N_ODD, ATT_HEADS, REL_SIZE), 0.1),
        "w_o_att": nrm(ks[18], (N_ODD, ATT_DIM, D_MODEL), ATT_DIM ** -0.5),
        "w_ffn_in": nrm(ks[19], (DEPTH, D_MODEL, 2 * D_FF), D_MODEL ** -0.5),
        "w_ffn_out": nrm(ks[20], (DEPTH, D_FF, D_MODEL), D_FF ** -0.5),
    }


def reference(x_prompt, x_sample, state_conv, state_gla, cache_k, cache_v,
              norm_mix, norm_ffn, w_in_ab, conv_w, gla_gk_w2, gla_gk_b, gla_onorm, w_out_ab,
              w_qkv, q_norm, k_norm, rel_bias, w_o_att, w_ffn_in, w_ffn_out):
    B, T, _ = x_prompt.shape
    dt = x_prompt.dtype
    conv0 = jnp.zeros((N_EVEN, B, CONV_WIDTH - 1, CONV_DIM), dt)
    gla0 = jnp.zeros((N_EVEN, B, GLA_HEADS, GLA_HEAD_K, GLA_HEAD_V), jnp.float32)
    kv0 = jnp.zeros((N_ODD, B, BAND_ROWS, ATT_HEADS, ATT_HEAD_DIM), dt)
    y_prompt, conv_p, gla_p, k_p, v_p = trunk(
        x_prompt, 0, min(BAND_ROWS, T), conv0, gla0, kv0, kv0,
        norm_mix, norm_ffn, w_in_ab, conv_w, gla_gk_w2, gla_gk_b, gla_onorm, w_out_ab,
        w_qkv, q_norm, k_norm, rel_bias, w_o_att, w_ffn_in, w_ffn_out)
    y_sample, conv_s, gla_s, k_s, v_s = trunk(
        x_sample, PAST_LEN, cache_k.shape[2], state_conv, state_gla, cache_k, cache_v,
        norm_mix, norm_ffn, w_in_ab, conv_w, gla_gk_w2, gla_gk_b, gla_onorm, w_out_ab,
        w_qkv, q_norm, k_norm, rel_bias, w_o_att, w_ffn_in, w_ffn_out)
    return (y_prompt, y_sample, conv_p, gla_p, k_p, v_p, conv_s, gla_s, k_s, v_s)
```

```cpp
#include <hip/hip_runtime.h>
#include <hip/hip_cooperative_groups.h>
#include <cstdio>
#include <cstdint>
namespace cg = cooperative_groups;
namespace pg8 {
#define PG8_LAS __attribute__((address_space(3)))
typedef unsigned short bf16_t;
typedef short bf16x8 __attribute__((ext_vector_type(8)));
typedef float f32x4 __attribute__((ext_vector_type(4)));
typedef unsigned u32x4 __attribute__((ext_vector_type(4)));
constexpr int BM = 256, BK = 64, HALF = 128, HTB = HALF * BK * 2  , STAGE_BYTES = 8 * HTB, NXCD = 8, WGM = 8;

__host__ __device__ __forceinline__ int lds_byte(int r, int c) { const int st = (r >> 4) * 2 + (c >> 5), rr = r & 15, cc = c & 31, ob = rr * 64 + cc * 2; return st * 1024 + (ob ^ (((ob >> 9) & 1) << 5)); }
__host__ __device__ __forceinline__ void stage_rc(int b, int& R, int& C) { const int st = b / 1024, sb = b % 1024, swz = sb ^ (((sb >> 9) & 1) << 5); R = (st >> 1) * 16 + swz / 64; C = (st & 1) * 32 + (swz % 64) / 2; }
__host__ __device__ __forceinline__ int perm32(int rho) { const int n = rho >> 4, i = rho & 15; return 8 * (i >> 2) + 4 * n + (i & 3); }

struct Unit { int pm, pn; };
struct Gemm { const bf16_t* A; const bf16_t* Bt; int M, N, K; };

struct StaticOrder {
    int nM, nN, nwg, G, c;
    __host__ __device__ void init(int M, int N, int G_, int c_) { nM = M / BM; nN = N / BM; nwg = nM * nN; G = G_; c = c_; }
    __host__ __device__ bool next(int i, Unit& u) const {
        const long L = (long)i * G + c; if (L >= nwg) return false;
        int wgid = (int)L; { const int q = nwg / NXCD, r = nwg % NXCD, xcd = wgid % NXCD, off = wgid / NXCD; wgid = (xcd < r ? xcd * (q + 1) : r * (q + 1) + (xcd - r) * q) + off; }
        const int nig = WGM * nN, gid = wgid / nig, fm = gid * WGM, gsz = (nM - fm) < WGM ? (nM - fm) : WGM;
        u.pm = fm + ((wgid % nig) % gsz); u.pn = (wgid % nig) / gsz; return true;
    }
    __device__ __forceinline__ void a_ready(const Unit&) const {}
    __device__ __forceinline__ void done(const Unit&) const {}
};
__device__ __forceinline__ unsigned cvt_pk_bf16(float lo, float hi) { unsigned r; asm volatile("v_cvt_pk_bf16_f32 %0, %1, %2" : "=v"(r) : "v"(lo), "v"(hi)); return r; }
typedef float f32x2 __attribute__((ext_vector_type(2)));
__device__ __forceinline__ float rinv_of(const float* ssq, int row) { const f32x4* q = (const f32x4*)(ssq + (size_t)row * 16); const f32x4 a = q[0], b = q[1], c = q[2], d = q[3];
    const f32x4 s = (a + b) + (c + d); return rsqrtf(((s[0] + s[1]) + (s[2] + s[3])) * (1.0f / 1024.0f) + 1e-6f); }
__device__ __forceinline__ u32x4 pack8(const f32x4& a, const f32x4& b) { u32x4 w; w.x = cvt_pk_bf16(a[0], a[1]); w.y = cvt_pk_bf16(a[2], a[3]); w.z = cvt_pk_bf16(b[0], b[1]); w.w = cvt_pk_bf16(b[2], b[3]); return w; }

struct EpiRowScale {
    static constexpr bool PERM = true, AFTER_DRAIN = false;
    bf16_t* O; int ldc; const float* ssq;
    __device__ __forceinline__ void operator()(const f32x4 (&acc)[2][2][4][2], const Unit& u, int wr, int wc, int fr, int fq) const {
        const int row0 = u.pm * BM + wr * 64 + fr, col0 = u.pn * BM + wc * 32 + 8 * fq;
#pragma unroll
        for (int ai = 0; ai < 2; ++ai)
#pragma unroll
            for (int m = 0; m < 4; ++m) { const int row = row0 + ai * HALF + m * 16; const float ri = rinv_of(ssq, row); bf16_t* rowp = O + (size_t)row * ldc + col0;
#pragma unroll
                for (int bj = 0; bj < 2; ++bj) { const f32x4 v0 = acc[ai][bj][m][0] * ri, v1 = acc[ai][bj][m][1] * ri; *(u32x4*)(rowp + bj * HALF) = pack8(v0, v1); } }
    }
};

struct EpiQKV {
    static constexpr bool PERM = true, AFTER_DRAIN = false;
    bf16_t* O; const float* ssq; const float* qn; const float* kn; float* kp; float* vp; float* ks; float* vs;
    __device__ __forceinline__ void operator()(const f32x4 (&acc)[2][2][4][2], const Unit& u, int wr, int wc, int fr, int fq) const {
        const int t = u.pn >> 2;
        const int row0 = u.pm * BM + wr * 64 + fr, lcol0 = u.pn * BM + wc * 64 + 8 * fq;
        const float* wsrc = (t == 0 ? qn : kn) + 8 * fq;
#pragma unroll
        for (int ai = 0; ai < 2; ++ai)
#pragma unroll
            for (int m = 0; m < 4; ++m) { const int row = row0 + ai * HALF + m * 16; const float ri = rinv_of(ssq, row);
                f32x4 v[2][2]; float ss = 0.f;
#pragma unroll
                for (int bj = 0; bj < 2; ++bj)
#pragma unroll
                    for (int n = 0; n < 2; ++n) { v[bj][n] = acc[ai][bj][m][n] * ri; const f32x4 x = v[bj][n]; ss += (x[0] * x[0] + x[1] * x[1]) + (x[2] * x[2] + x[3] * x[3]); }
                if (t < 2) { ss += __shfl_xor(ss, 16); ss += __shfl_xor(ss, 32); const float r2 = rsqrtf(ss * (1.0f / 64.0f) + 1e-6f);
#pragma unroll
                    for (int bj = 0; bj < 2; ++bj)
#pragma unroll
                        for (int n = 0; n < 2; ++n) v[bj][n] = v[bj][n] * r2 * *(const f32x4*)(wsrc + 32 * bj + 4 * n); }
                bf16_t* rowp = O + (size_t)row * 3072 + lcol0;
#pragma unroll
                for (int bj = 0; bj < 2; ++bj) *(u32x4*)(rowp + 32 * bj) = pack8(v[bj][0], v[bj][1]);
                if (t >= 1) { float* dst = nullptr;
                    if (row < 16384) { const int b = row >> 12, tt = row & 4095; if (tt >= 3584) dst = (t == 1 ? kp : vp) + ((size_t)(b * 512 + tt - 3584) * 1024); }
                    else { const int rs = row - 16384, b = rs >> 6, tt = rs & 63; dst = (t == 1 ? ks : vs) + ((size_t)(b * 512 + 448 + tt) * 1024); }
                    if (dst) { dst += (lcol0 & 1023);
#pragma unroll
                        for (int bj = 0; bj < 2; ++bj) { *(f32x4*)(dst + 32 * bj) = v[bj][0]; *(f32x4*)(dst + 32 * bj + 4) = v[bj][1]; } } }
            }
    }
};

struct EpiResid {
    static constexpr bool PERM = false, AFTER_DRAIN = false;
    float* X; bf16_t* XB; float* ssq_next;
    __device__ __forceinline__ void operator()(const f32x4 (&acc)[2][2][4][2], const Unit& u, int wr, int wc, int fr, int fq) const {
        typedef unsigned u32x2 __attribute__((ext_vector_type(2)));
        const int row0 = u.pm * BM + wr * 64 + fr, col0 = u.pn * BM + wc * 32 + 4 * fq;
#pragma unroll
        for (int ai = 0; ai < 2; ++ai)
#pragma unroll
            for (int m = 0; m < 4; ++m) { const int row = row0 + ai * HALF + m * 16; float* xr = X + (size_t)row * 1024 + col0; bf16_t* br = XB + (size_t)row * 1024 + col0; float ss = 0.f;
#pragma unroll
                for (int bj = 0; bj < 2; ++bj)
#pragma unroll
                    for (int n = 0; n < 2; ++n) { const f32x4 x = *(const f32x4*)(xr + bj * HALF + n * 16) + acc[ai][bj][m][n]; *(f32x4*)(xr + bj * HALF + n * 16) = x;
                        ss += (x[0] * x[0] + x[1] * x[1]) + (x[2] * x[2] + x[3] * x[3]); u32x2 w; w.x = cvt_pk_bf16(x[0], x[1]); w.y = cvt_pk_bf16(x[2], x[3]); *(u32x2*)(br + bj * HALF + n * 16) = w; }
                ss += __shfl_xor(ss, 16); ss += __shfl_xor(ss, 32);
                if (fq == 0) ssq_next[(size_t)row * 16 + u.pn * 4 + wc] = ss;
                asm volatile("" ::: "memory"); }
    }
};

struct EpiSwiGLU {
    static constexpr bool PERM = true, AFTER_DRAIN = false;
    bf16_t* H; const float* ssq;
    __device__ __forceinline__ void operator()(const f32x4 (&acc)[2][2][4][2], const Unit& u, int wr, int wc, int fr, int fq) const {
        const int row0 = u.pm * BM + wr * 64 + fr, col0 = u.pn * HALF + wc * 32 + 8 * fq;
#pragma unroll
        for (int ai = 0; ai < 2; ++ai)
#pragma unroll
            for (int m = 0; m < 4; ++m) { const int row = row0 + ai * HALF + m * 16; const float ri = rinv_of(ssq, row); f32x4 h[2];
#pragma unroll
                for (int n = 0; n < 2; ++n) { const f32x4 g = acc[ai][0][m][n] * ri, up = acc[ai][1][m][n] * ri;
#pragma unroll
                    for (int j = 0; j < 4; ++j) h[n][j] = g[j] * __builtin_amdgcn_rcpf(1.0f + __expf(-g[j])) * up[j]; }
                *(u32x4*)(H + (size_t)row * 2816 + col0) = pack8(h[0], h[1]); }
    }
};

template <class Epi, class Sched, bool ALIGN_EPI = false, bool SP2 = false>
__device__ __forceinline__ void gemm_phase(PG8_LAS unsigned char* lds, const Gemm g, const Sched& S, const Epi& E) {
    int tid_; asm volatile("v_mbcnt_lo_u32_b32 %0, -1, 0\n\tv_mbcnt_hi_u32_b32 %0, -1, %0" : "=v"(tid_)); tid_ += __builtin_amdgcn_readfirstlane(threadIdx.x >> 6) * 64;
    const int tid = tid_, wid = __builtin_amdgcn_readfirstlane(tid >> 6), lane = tid & 63, wr = wid >> 2, wc = wid & 3, fr = lane & 15, fq = lane >> 4;
    const int K = g.K, nt = K / BK;
    unsigned voffA[2], voffB[2];
#pragma unroll
    for (int i = 0; i < 2; ++i) { int R, C; stage_rc(tid * 16 + i * 8192, R, C); const int Rb = Epi::PERM ? ((R & ~31) + perm32(R & 31)) : R;
        voffA[i] = (unsigned)(R * K + C) * 2u; voffB[i] = (unsigned)(Rb * K + C) * 2u; }
    const size_t kstep = (size_t)(BK * 2);
    const size_t hstep = (size_t)HALF * K * 2;
    const size_t tstep = 2 * hstep;
    const unsigned ldsw = (unsigned)wid * 1024u;
    const int aoff = lds_byte(wr * 64 + fr, fq * 8), boff = lds_byte(wc * 32 + fr, fq * 8);
#define PG8_SA(b, h) (((b) * 2 + (h)) * HTB)
#define PG8_SB(b, h) ((4 + (b) * 2 + (h)) * HTB)
#define PG8_STAGE(bufoff, gbase, voff) do { _Pragma("unroll") for (int _i = 0; _i < 2; ++_i) \
        __builtin_amdgcn_global_load_lds((const unsigned*)((const char*)(gbase) + (voff)[_i]), (PG8_LAS unsigned*)(lds + (bufoff) + ldsw + _i * 8192), 16, 0, 0); } while (0)
#define PG8_LDA(dst, b, h) do { _Pragma("unroll") for (int m = 0; m < 4; ++m) _Pragma("unroll") for (int k = 0; k < 2; ++k) dst[m][k] = *(const PG8_LAS bf16x8*)(lds + PG8_SA(b, h) + aoff + m * 2048 + k * 1024); } while (0)
#define PG8_LDB(dst, b, h) do { _Pragma("unroll") for (int n = 0; n < 2; ++n) _Pragma("unroll") for (int k = 0; k < 2; ++k) dst[n][k] = *(const PG8_LAS bf16x8*)(lds + PG8_SB(b, h) + boff + n * 2048 + k * 1024); } while (0)
#define PG8_MMA(ai, bj, At, Bt) do { __builtin_amdgcn_s_setprio(1); _Pragma("unroll") for (int m = 0; m < 4; ++m) _Pragma("unroll") for (int n = 0; n < 2; ++n) _Pragma("unroll") for (int k = 0; k < 2; ++k) \
        acc[ai][bj][m][n] = __builtin_amdgcn_mfma_f32_16x16x32_bf16(Bt[n][k], At[m][k], acc[ai][bj][m][n], 0, 0, 0); __builtin_amdgcn_s_setprio(0); } while (0)
#define PG8_WAIT_V(n) asm volatile("s_waitcnt vmcnt(" #n ")" ::: "memory")
#define PG8_WAIT_L(n) asm volatile("s_waitcnt lgkmcnt(" #n ")" ::: "memory")
#define PG8_BAR __builtin_amdgcn_s_barrier()
#define PG8_SCHED __builtin_amdgcn_sched_barrier(0)
    Unit cur, nxt; int ui = 0;
    if (!S.next(0, cur)) return;
    f32x4 acc[2][2][4][2];
#pragma unroll
    for (int a = 0; a < 2; ++a)
#pragma unroll
        for (int b = 0; b < 2; ++b)
#pragma unroll
            for (int m = 0; m < 4; ++m)
#pragma unroll
                for (int n = 0; n < 2; ++n) acc[a][b][m][n] = (f32x4){0.f, 0.f, 0.f, 0.f};
    bf16x8 At[4][2], B0[2][2], B1[2][2];
    const char* cA = (const char*)g.A + (size_t)cur.pm * tstep; const char* cB = (const char*)g.Bt + (size_t)cur.pn * tstep;
    S.a_ready(cur);
    if constexpr (SP2) {
        PG8_STAGE(PG8_SB(0, 0), cB, voffB); PG8_STAGE(PG8_SB(0, 1), cB + hstep, voffB); PG8_STAGE(PG8_SA(0, 0), cA, voffA); PG8_STAGE(PG8_SA(0, 1), cA + hstep, voffA);
        if (wr == 1) PG8_BAR;
        PG8_WAIT_V(2); PG8_BAR;
        PG8_STAGE(PG8_SB(1, 0), cB + kstep, voffB); PG8_STAGE(PG8_SA(1, 0), cA + kstep, voffA); PG8_STAGE(PG8_SB(1, 1), cB + hstep + kstep, voffB);
        PG8_WAIT_V(6); PG8_BAR;
    } else {
        PG8_STAGE(PG8_SB(0, 0), cB, voffB); PG8_STAGE(PG8_SA(0, 0), cA, voffA); PG8_STAGE(PG8_SB(0, 1), cB + hstep, voffB); PG8_STAGE(PG8_SA(0, 1), cA + hstep, voffA);
        if (wr == 1) PG8_BAR;
        PG8_WAIT_V(4); PG8_BAR;
        PG8_STAGE(PG8_SB(1, 0), cB + kstep, voffB); PG8_STAGE(PG8_SA(1, 0), cA + kstep, voffA); PG8_STAGE(PG8_SB(1, 1), cB + hstep + kstep, voffB);
        PG8_WAIT_V(6); PG8_BAR;
    }
    for (;;) {
        const bool has_next = S.next(ui + 1, nxt);
        const char* nA = has_next ? (const char*)g.A + (size_t)nxt.pm * tstep : cA; const char* nB = has_next ? (const char*)g.Bt + (size_t)nxt.pn * tstep : cB;
        for (int t = 0; t < nt; t += 2) {
            const bool last = (t == nt - 2);
            const char* a1 = cA + (size_t)(t + 1) * kstep;
            const char* a2 = last ? nA : cA + (size_t)(t + 2) * kstep; const char* b2 = last ? nB : cB + (size_t)(t + 2) * kstep;
            const char* a3 = a2 + kstep; const char* b3 = b2 + kstep;
            if (last && has_next) S.a_ready(nxt);
            if constexpr (SP2) {
            PG8_LDB(B0, 0, 0); PG8_LDB(B1, 0, 1); PG8_SCHED; PG8_LDA(At, 0, 0); PG8_STAGE(PG8_SA(1, 1), a1 + hstep, voffA);
            PG8_WAIT_V(8); PG8_WAIT_L(0); PG8_BAR; PG8_MMA(0, 0, At, B0); PG8_MMA(0, 1, At, B1); PG8_BAR; PG8_SCHED;
            PG8_LDA(At, 0, 1); PG8_STAGE(PG8_SB(0, 0), b2, voffB); PG8_STAGE(PG8_SB(0, 1), b2 + hstep, voffB); PG8_STAGE(PG8_SA(0, 0), a2, voffA);
            PG8_WAIT_V(8); PG8_WAIT_L(0); PG8_BAR; PG8_MMA(1, 0, At, B0); PG8_MMA(1, 1, At, B1); PG8_BAR; PG8_SCHED;
            PG8_LDB(B0, 1, 0); PG8_LDB(B1, 1, 1); PG8_SCHED; PG8_LDA(At, 1, 0); PG8_STAGE(PG8_SA(0, 1), a2 + hstep, voffA);
            PG8_WAIT_V(8); PG8_WAIT_L(0); PG8_BAR; PG8_MMA(0, 0, At, B0); PG8_MMA(0, 1, At, B1); PG8_BAR; PG8_SCHED;
            PG8_LDA(At, 1, 1); PG8_STAGE(PG8_SB(1, 0), b3, voffB); PG8_STAGE(PG8_SB(1, 1), b3 + hstep, voffB); PG8_STAGE(PG8_SA(1, 0), a3, voffA);
            PG8_WAIT_V(8); PG8_WAIT_L(0); PG8_BAR; PG8_MMA(1, 0, At, B0); PG8_MMA(1, 1, At, B1); PG8_BAR; PG8_SCHED;
            } else {
            PG8_LDB(B0, 0, 0); PG8_SCHED; PG8_LDA(At, 0, 0); PG8_STAGE(PG8_SA(1, 1), a1 + hstep, voffA);
            PG8_WAIT_L(8); PG8_BAR; PG8_WAIT_L(0); PG8_MMA(0, 0, At, B0); PG8_BAR; PG8_SCHED;
            PG8_LDB(B1, 0, 1); PG8_STAGE(PG8_SB(0, 0), b2, voffB);
            PG8_BAR; PG8_WAIT_L(0); PG8_MMA(0, 1, At, B1); PG8_BAR;
            PG8_LDA(At, 0, 1); PG8_STAGE(PG8_SA(0, 0), a2, voffA);
            PG8_BAR; PG8_WAIT_L(0); PG8_MMA(1, 0, At, B0); PG8_BAR; PG8_SCHED;
            PG8_STAGE(PG8_SB(0, 1), b2 + hstep, voffB);
            PG8_WAIT_V(6); PG8_BAR; PG8_MMA(1, 1, At, B1); PG8_BAR;
            PG8_LDB(B0, 1, 0); PG8_SCHED; PG8_LDA(At, 1, 0); PG8_STAGE(PG8_SA(0, 1), a2 + hstep, voffA);
            PG8_WAIT_L(8); PG8_BAR; PG8_WAIT_L(0); PG8_MMA(0, 0, At, B0); PG8_BAR; PG8_SCHED;
            PG8_LDB(B1, 1, 1); PG8_STAGE(PG8_SB(1, 0), b3, voffB);
            PG8_BAR; PG8_WAIT_L(0); PG8_MMA(0, 1, At, B1); PG8_BAR;
            PG8_LDA(At, 1, 1); PG8_STAGE(PG8_SA(1, 0), a3, voffA);
            PG8_BAR; PG8_WAIT_L(0); PG8_MMA(1, 0, At, B0); PG8_BAR; PG8_SCHED;
            PG8_STAGE(PG8_SB(1, 1), b3 + hstep, voffB);
            PG8_WAIT_V(6); PG8_BAR; PG8_MMA(1, 1, At, B1); PG8_BAR;
            }
        }
        if constexpr (ALIGN_EPI) { if (wr == 0) PG8_BAR; }
        if constexpr (!Epi::AFTER_DRAIN) { E(acc, cur, wr, wc, fr, fq); S.done(cur); }
        if (!has_next) break;
#pragma unroll
        for (int a = 0; a < 2; ++a)
#pragma unroll
            for (int b = 0; b < 2; ++b)
#pragma unroll
                for (int m = 0; m < 4; ++m)
#pragma unroll
                    for (int n = 0; n < 2; ++n) acc[a][b][m][n] = (f32x4){0.f, 0.f, 0.f, 0.f};
        cur = nxt; cA = nA; cB = nB; ++ui;
        if constexpr (ALIGN_EPI) { if (wr == 1) PG8_BAR; }
    }
    PG8_WAIT_V(0);
    if constexpr (!ALIGN_EPI) { if (wr == 0) PG8_BAR; }
    PG8_BAR;
    if constexpr (Epi::AFTER_DRAIN) { E.fused(acc, cur, wr, wc, fr, fq, lds, wid, lane); S.done(cur); }
#undef PG8_SA
#undef PG8_SB
#undef PG8_STAGE
#undef PG8_LDA
#undef PG8_LDB
#undef PG8_MMA
#undef PG8_WAIT_V
#undef PG8_WAIT_L
#undef PG8_BAR
#undef PG8_SCHED
}
}

#define LAS __attribute__((address_space(3)))
typedef unsigned short bf16;
typedef float f32x4 __attribute__((ext_vector_type(4)));
typedef unsigned u32x4 __attribute__((ext_vector_type(4)));
typedef unsigned u32x2 __attribute__((ext_vector_type(2)));
typedef short bf16x8 __attribute__((ext_vector_type(8)));
typedef short s16x4 __attribute__((ext_vector_type(4)));

constexpr int DM = 1024, TP = 16384, TS = 512, TT = TP + TS, NCHUNK = TT / 64;
constexpr int N_IN = 3328, N_IN_SRC = 3088, N_QKV = 3072, N_FF2 = 5632, DFF = 2816;
constexpr int C_CG = 0, C_BG = 512, C_HC = 1024, C_Q = 1536, C_K = 1792, C_V = 2048, C_G = 2560, C_GK = 3072;
constexpr int NGLA = NCHUNK * 4;
constexpr int NATT = NCHUNK * 16;
constexpr size_t O_YP = 0, O_CONVP = (size_t)TT * DM, O_GLAP = O_CONVP + 2 * 4 * 2 * 512, O_KP = O_GLAP + 2 * 4 * 4 * 64 * 128, O_VP = O_KP + (size_t)2 * 4 * 512 * 1024,
                 O_CONVS = O_VP + (size_t)2 * 4 * 512 * 1024, O_GLAS = O_CONVS + 2 * 8 * 2 * 512, O_KS = O_GLAS + 2 * 8 * 4 * 64 * 128, O_VS = O_KS + (size_t)2 * 8 * 512 * 1024, O_END = O_VS + (size_t)2 * 8 * 512 * 1024;
static_assert(O_END == 43278336, "output size");
constexpr size_t W_IN = 0, W_QKV = W_IN + (size_t)2 * N_IN * 1024 * 2, W_FFI = W_QKV + (size_t)2 * N_QKV * 1024 * 2, W_FFO = W_FFI + (size_t)4 * N_FF2 * 1024 * 2, W_OUT = W_FFO + (size_t)4 * 1024 * DFF * 2,
                 W_O = W_OUT + (size_t)2 * 1024 * 1024 * 2, W_XB = W_O + (size_t)2 * 1024 * 1024 * 2, W_PROJ = W_XB + (size_t)TT * 1024 * 2, W_MIX = W_PROJ + (size_t)TT * N_IN * 2,
                 W_ST = W_MIX + (size_t)TT * 1024 * 2, W_QE = W_ST + (size_t)NGLA * 8192 * 2, W_KE = W_QE + (size_t)TT * 256 * 2, W_DEC = W_KE + (size_t)TT * 256 * 2, W_SSQ = W_DEC + (size_t)NCHUNK * 256 * 4,
                 W_BAR = W_SSQ + (size_t)9 * TT * 16 * 4, W_END = W_BAR + 16384;
static_assert((size_t)NGLA * 8192 * 4 == (size_t)TT * 1024 * 2, "UT overlays MIX");
constexpr int WAVE_LDS = 18432, LDS_CTL = 8 * WAVE_LDS, LDS_BYTES = LDS_CTL + 64;
static_assert(LDS_BYTES >= pg8::STAGE_BYTES, "lds");

struct Params { const float* in[21]; float* out; unsigned char* ws; };

__device__ __forceinline__ float bf2f(unsigned short b) { return __uint_as_float(((unsigned)b) << 16); }
__device__ __forceinline__ float bflo(unsigned w) { return __uint_as_float(w << 16); }
__device__ __forceinline__ float bfhi(unsigned w) { return __uint_as_float(w & 0xffff0000u); }
__device__ __forceinline__ unsigned pk2(float lo, float hi) { return pg8::cvt_pk_bf16(lo, hi); }
__device__ __forceinline__ unsigned short f2bf(float f) { return (unsigned short)(pk2(f, 0.f) & 0xffffu); }
__device__ __forceinline__ float wave_sum(float v) {
#pragma unroll
    for (int o = 1; o < 64; o <<= 1) v += __shfl_xor(v, o);
    return v;
}
__device__ __forceinline__ float silu_f(float g) { return g * __builtin_amdgcn_rcpf(1.0f + __expf(-g)); }
#define CBAR() asm volatile("" ::: "memory")
#define OPQ(x) ({ int _t = (x); asm volatile("" : "+v"(_t)); _t; })
#define LANE_NOW() ({ int _l; asm volatile("v_mbcnt_lo_u32_b32 %0, -1, 0\n\tv_mbcnt_hi_u32_b32 %0, -1, %0" : "=v"(_l)); _l; })
#define LDS_WAIT() asm volatile("s_waitcnt lgkmcnt(0)" ::: "memory")
__device__ __forceinline__ s16x4 tr4(LAS const unsigned char* p) { return __builtin_bit_cast(s16x4, __builtin_amdgcn_ds_read_tr16_b64_v4i16((LAS s16x4*)p)); }
__device__ __forceinline__ bf16x8 frag_tr2(LAS const unsigned char* img, int stride, int rlo, int rhi, int c0, int lane) {
    const int g = lane >> 4, q = (lane & 15) >> 2, p = lane & 3;
    const s16x4 lo = tr4(img + (rlo + 4 * g + q) * stride + (c0 + 4 * p) * 2), hi = tr4(img + (rhi + 4 * g + q) * stride + (c0 + 4 * p) * 2);
    return (bf16x8){lo[0], lo[1], lo[2], lo[3], hi[0], hi[1], hi[2], hi[3]};
}
__device__ __forceinline__ bf16x8 frag_tr(LAS const unsigned char* img, int stride, int k0, int c0, int lane) {
    const int g = lane >> 4, q = (lane & 15) >> 2, p = lane & 3;
    LAS const unsigned char* a = img + (k0 + 8 * g + q) * stride + (c0 + 4 * p) * 2;
    const s16x4 lo = tr4(a), hi = tr4(a + 4 * stride);
    return (bf16x8){lo[0], lo[1], lo[2], lo[3], hi[0], hi[1], hi[2], hi[3]};
}
__device__ __forceinline__ bf16x8 pack_frag(const f32x4& a, const f32x4& b) { u32x4 w; w.x = pk2(a[0], a[1]); w.y = pk2(a[2], a[3]); w.z = pk2(b[0], b[1]); w.w = pk2(b[2], b[3]); return __builtin_bit_cast(bf16x8, w); }
#define MFMA16(a, b, c) __builtin_amdgcn_mfma_f32_16x16x32_bf16((a), (b), (c), 0, 0, 0)

__device__ __forceinline__ void transpose_item(const float* W, int K, int Nsrc, int Ndst, bf16* WT, const float* gs, int mode, LAS float* scr, int item, int lane) {
    const int nblk = Ndst / 32, kb = item / nblk, nb = item % nblk, k0 = 64 * kb, n0d = 32 * nb;
    int n0s = n0d;
    if (mode == 1) { const int gi = nb & 7, bj = gi >> 2, wc = gi & 3; n0s = (nb >> 3) * 256 + 32 * (wc * 2 + bj); }
    else if (mode == 2) { const int gi = nb & 7, bj = gi >> 2, r = gi & 3; n0s = bj * DFF + (nb >> 3) * 128 + 32 * r; }
    const int ns = n0s + (lane & 31); const bool ok = ns < Nsrc;
    float wv_[32];
#pragma unroll
    for (int i = 0; i < 32; ++i) { const int kk = 2 * i + (lane >> 5); wv_[i] = ok ? W[(size_t)(k0 + kk) * Nsrc + ns] : 0.f; }
    if (gs) {
#pragma unroll
        for (int i = 0; i < 32; ++i) wv_[i] *= gs[k0 + 2 * i + (lane >> 5)]; }
#pragma unroll
    for (int i = 0; i < 32; ++i) scr[(2 * i + (lane >> 5)) * 33 + (lane & 31)] = wv_[i];
    LDS_WAIT();
    const int c = lane & 7;
#pragma unroll
    for (int j = 0; j < 4; ++j) { const int n = (lane >> 3) + 8 * j; const LAS float* s = scr + (8 * c) * 33 + n;
        u32x4 o; o.x = pk2(s[0 * 33], s[1 * 33]); o.y = pk2(s[2 * 33], s[3 * 33]); o.z = pk2(s[4 * 33], s[5 * 33]); o.w = pk2(s[6 * 33], s[7 * 33]);
        *(u32x4*)(WT + (size_t)(n0d + n) * K + k0 + 8 * c) = o; }
    LDS_WAIT();
}

__device__ __forceinline__ void prologue(const Params& p, LAS unsigned char* lds, int gw, int NGW, int gtid, int NT, int wave, int lane) {
    LAS float* scr = (LAS float*)(lds + wave * WAVE_LDS);
    unsigned char* ws = p.ws;
    constexpr int I_IN = 16 * (N_IN / 32), I_QKV = 16 * (N_QKV / 32), I_FFI = 16 * (N_FF2 / 32), I_FFO = (DFF / 64) * 32, I_SQ = 16 * 32;
    constexpr int NITEMS = 2 * I_IN + 2 * I_QKV + 4 * I_FFI + 4 * I_FFO + 2 * I_SQ + 2 * I_SQ;
    for (int it = gw; it < NITEMS; it += NGW) {
        int r = it;
        if (r < 2 * I_IN) { const int e = r / I_IN; r -= e * I_IN; transpose_item(p.in[8] + (size_t)e * 1024 * N_IN_SRC, 1024, N_IN_SRC, N_IN, (bf16*)(ws + W_IN) + (size_t)e * N_IN * 1024, p.in[6] + (2 * e) * 1024, 0, scr, r, lane); continue; } r -= 2 * I_IN;
        if (r < 2 * I_QKV) { const int o = r / I_QKV; r -= o * I_QKV; transpose_item(p.in[14] + (size_t)o * 1024 * N_QKV, 1024, N_QKV, N_QKV, (bf16*)(ws + W_QKV) + (size_t)o * N_QKV * 1024, p.in[6] + (2 * o + 1) * 1024, 1, scr, r, lane); continue; } r -= 2 * I_QKV;
        if (r < 4 * I_FFI) { const int l = r / I_FFI; r -= l * I_FFI; transpose_item(p.in[19] + (size_t)l * 1024 * N_FF2, 1024, N_FF2, N_FF2, (bf16*)(ws + W_FFI) + (size_t)l * N_FF2 * 1024, p.in[7] + l * 1024, 2, scr, r, lane); continue; } r -= 4 * I_FFI;
        if (r < 4 * I_FFO) { const int l = r / I_FFO; r -= l * I_FFO; transpose_item(p.in[20] + (size_t)l * DFF * 1024, DFF, 1024, 1024, (bf16*)(ws + W_FFO) + (size_t)l * 1024 * DFF, nullptr, 0, scr, r, lane); continue; } r -= 4 * I_FFO;
        if (r < 2 * I_SQ) { const int e = r / I_SQ; r -= e * I_SQ; transpose_item(p.in[13] + (size_t)e * 1024 * 1024, 1024, 1024, 1024, (bf16*)(ws + W_OUT) + (size_t)e * 1024 * 1024, nullptr, 0, scr, r, lane); continue; } r -= 2 * I_SQ;
        { const int o = r / I_SQ; r -= o * I_SQ; transpose_item(p.in[18] + (size_t)o * 1024 * 1024, 1024, 1024, 1024, (bf16*)(ws + W_O) + (size_t)o * 1024 * 1024, nullptr, 0, scr, r, lane); }
    }
    float* ssq = (float*)(ws + W_SSQ); bf16* xb = (bf16*)(ws + W_XB);
    for (int m = gw; m < TT; m += NGW) {
        const float* src = (m < TP) ? p.in[0] + (size_t)m * DM : p.in[1] + (size_t)(m - TP) * DM;
        const f32x4* s4 = (const f32x4*)src + lane; f32x4 v[4]; float ss = 0.f;
#pragma unroll
        for (int j = 0; j < 4; ++j) { v[j] = s4[64 * j]; ss += (v[j][0] * v[j][0] + v[j][1] * v[j][1]) + (v[j][2] * v[j][2] + v[j][3] * v[j][3]); }
        ss = wave_sum(ss);
        f32x4* o4 = (f32x4*)(p.out + (size_t)m * DM) + lane; u32x2* b2 = (u32x2*)(xb + (size_t)m * DM) + lane;
#pragma unroll
        for (int j = 0; j < 4; ++j) { o4[64 * j] = v[j]; u32x2 w; w.x = pk2(v[j][0], v[j][1]); w.y = pk2(v[j][2], v[j][3]); b2[64 * j] = w; }
        if (lane < 16) ssq[(size_t)m * 16 + lane] = (lane == 0) ? ss : 0.f;
    }
    constexpr int PER = 448 * 256, NCP = 2 * 8 * PER;
    for (int i0 = gtid; i0 < 2 * NCP; i0 += 4 * NT) { f32x4 v[4];
#pragma unroll
        for (int q = 0; q < 4; ++q) { const int i = i0 + q * NT; if (i < 2 * NCP) { const int t = i / NCP, j = i % NCP, ob = j / PER, rem = j % PER; v[q] = *((const f32x4*)(p.in[4 + t] + ((size_t)ob * 512 + 64) * 1024) + rem); } }
#pragma unroll
        for (int q = 0; q < 4; ++q) { const int i = i0 + q * NT; if (i < 2 * NCP) { const int t = i / NCP, j = i % NCP, ob = j / PER, rem = j % PER; *((f32x4*)(p.out + (t ? O_VS : O_KS) + (size_t)ob * 512 * 1024) + rem) = v[q]; } } }
}

__device__ __forceinline__ void unpack8(const u32x4& w, float* f) { f[0] = bflo(w.x); f[1] = bfhi(w.x); f[2] = bflo(w.y); f[3] = bfhi(w.y); f[4] = bflo(w.z); f[5] = bfhi(w.z); f[6] = bflo(w.w); f[7] = bfhi(w.w); }
__device__ __forceinline__ void conv_u(const bf16* proj, int row, int c, float* u) {
    float a[8], b[8]; unpack8(*(const u32x4*)(proj + (size_t)row * N_IN + C_CG + c), a); unpack8(*(const u32x4*)(proj + (size_t)row * N_IN + C_HC + c), b);
#pragma unroll
    for (int k = 0; k < 8; ++k) u[k] = a[k] * b[k];
}
__device__ __forceinline__ void conv_phase(const Params& p, int e, int gtid, int NT) {
    const bf16* proj = (const bf16*)(p.ws + W_PROJ); bf16* mix = (bf16*)(p.ws + W_MIX);
    const float* cw = p.in[9] + e * 3 * 512;
    for (int idx = gtid; idx < TT * 64; idx += NT) {
        const int row = idx >> 6, c = (idx & 63) * 8;
        int b, t, T; const float* prev = nullptr; float* st;
        if (row < TP) { b = row >> 12; t = row & 4095; T = 4096; st = p.out + O_CONVP + (size_t)((e * 4 + b) * 2) * 512; }
        else { const int rs = row - TP; b = rs >> 6; t = rs & 63; T = 64; prev = p.in[2] + (size_t)((e * 8 + b) * 2) * 512; st = p.out + O_CONVS + (size_t)((e * 8 + b) * 2) * 512; }
        float u2[8], u1[8], u0[8];
        conv_u(proj, row, c, u2);
        if (t >= 1) conv_u(proj, row - 1, c, u1); else {
#pragma unroll
            for (int k = 0; k < 8; ++k) u1[k] = prev ? prev[512 + c + k] : 0.f; }
        if (t >= 2) conv_u(proj, row - 2, c, u0); else {
#pragma unroll
            for (int k = 0; k < 8; ++k) u0[k] = prev ? prev[t * 512 + c + k] : 0.f; }
        float bg[8]; unpack8(*(const u32x4*)(proj + (size_t)row * N_IN + C_BG + c), bg);
        float y[8];
#pragma unroll
        for (int k = 0; k < 8; ++k) y[k] = bg[k] * (cw[c + k] * u0[k] + cw[512 + c + k] * u1[k] + cw[1024 + c + k] * u2[k]);
        u32x4 w; w.x = pk2(y[0], y[1]); w.y = pk2(y[2], y[3]); w.z = pk2(y[4], y[5]); w.w = pk2(y[6], y[7]);
        *(u32x4*)(mix + (size_t)row * DM + c) = w;
        if (t >= T - 2) { float* d = st + (t - (T - 2)) * 512 + c; *(f32x4*)d = (f32x4){u2[0], u2[1], u2[2], u2[3]}; *(f32x4*)(d + 4) = (f32x4){u2[4], u2[5], u2[6], u2[7]}; }
    }
}

__device__ __forceinline__ void gla_local(const Params& p, int e, LAS unsigned char* wl, int gw, int NGW, int lane) {
    const bf16* proj = (const bf16*)(p.ws + W_PROJ); bf16* QE = (bf16*)(p.ws + W_QE); bf16* KE = (bf16*)(p.ws + W_KE);
    float* UT = (float*)(p.ws + W_MIX); float* DEC = (float*)(p.ws + W_DEC);
    LAS unsigned char* keimg = wl; LAS unsigned char* vimg = wl + 64 * 144;
    const int g = lane >> 4;
    for (int item = gw; item < NGLA; item += NGW) {
        const int ci = item >> 2, h = item & 3, row0 = ci * 64, ch = h * 64 + lane;
        float w2c[16];
#pragma unroll
        for (int r = 0; r < 16; ++r) w2c[r] = p.in[10][(size_t)(e * 16 + r) * 256 + ch];
        const float bias = p.in[11][e * 256 + ch];
        float gl[16];
        { const bf16* gp = proj + (size_t)(row0 + lane) * N_IN + C_GK; float t8[8]; unpack8(*(const u32x4*)gp, t8);
#pragma unroll
          for (int r = 0; r < 8; ++r) gl[r] = t8[r];
          unpack8(*(const u32x4*)(gp + 8), t8);
#pragma unroll
          for (int r = 0; r < 8; ++r) gl[8 + r] = t8[r]; }
        float bc = 0.f;
#pragma unroll 1
        for (int jh = 0; jh < 2; ++jh) {
            unsigned kq[32];
#pragma unroll
            for (int jj = 0; jj < 32; ++jj) { const bf16* rp = proj + (size_t)(row0 + jh * 32 + jj) * N_IN + ch; kq[jj] = (unsigned)rp[C_Q] | ((unsigned)rp[C_K] << 16); }
#pragma unroll
            for (int jj = 0; jj < 32; ++jj) {
                const int j = jh * 32 + jj;
                float z = bias;
#pragma unroll
                for (int r = 0; r < 16; ++r) z += __builtin_bit_cast(float, __builtin_amdgcn_readlane(__builtin_bit_cast(int, gl[r]), j)) * w2c[r];
                const float la = (fminf(z, 0.f) - log1pf(__expf(-fabsf(z)))) * (1.0f / 16.0f);
                bc += la;
                const float qv = bflo(kq[jj]) * 0.125f * __expf(bc), kv = bfhi(kq[jj]) * __expf(-bc);
                const unsigned short qb = f2bf(qv), kb = f2bf(kv);
                QE[(size_t)(row0 + j) * 256 + ch] = qb; KE[(size_t)(row0 + j) * 256 + ch] = kb;
                *(LAS unsigned short*)(keimg + j * 144 + lane * 2) = kb;
            }
        }
        DEC[ci * 256 + ch] = __expf(bc);
#pragma unroll 1
        for (int vh = 0; vh < 2; ++vh) {
#pragma unroll
            for (int it = 0; it < 8; ++it) { const int j = it * 8 + (lane >> 3), seg = lane & 7;
                *(LAS u32x4*)(vimg + j * 144 + seg * 16) = *(const u32x4*)(proj + (size_t)(row0 + j) * N_IN + C_V + h * 128 + vh * 64 + seg * 8); }
            CBAR();
            f32x4 acc[4][4];
#pragma unroll
            for (int a = 0; a < 4; ++a)
#pragma unroll
                for (int b = 0; b < 4; ++b) acc[a][b] = (f32x4){0.f, 0.f, 0.f, 0.f};
#pragma unroll
            for (int ks = 0; ks < 2; ++ks) {
                bf16x8 A[4], B[4];
#pragma unroll
                for (int a = 0; a < 4; ++a) { A[a] = frag_tr(vimg, 144, 32 * ks, 16 * a, lane); B[a] = frag_tr(keimg, 144, 32 * ks, 16 * a, lane); }
#pragma unroll
                for (int a = 0; a < 4; ++a)
#pragma unroll
                    for (int b = 0; b < 4; ++b) acc[a][b] = MFMA16(A[a], B[b], acc[a][b]);
            }
            float* ut = UT + (size_t)item * 8192 + (size_t)(vh * 64 + 4 * g) * 64 + (lane & 15);
#pragma unroll
            for (int a = 0; a < 4; ++a)
#pragma unroll
                for (int b = 0; b < 4; ++b)
#pragma unroll
                    for (int r = 0; r < 4; ++r) ut[(16 * a + r) * 64 + 16 * b] = acc[a][b][r];
            CBAR();
        }
    }
}

__device__ __forceinline__ void gla_scan(const Params& p, int e, int gtid, int NT) {
    const float* UT = (const float*)(p.ws + W_MIX); const float* DEC = (const float*)(p.ws + W_DEC); bf16* ST = (bf16*)(p.ws + W_ST);
    for (int w = gtid; w < 48 * 2048; w += NT) {
        const int bh = w >> 11, rem = w & 2047, v = rem >> 4, dq = rem & 15;
        if (bh < 16) { const int b = bh >> 2, h = bh & 3; f32x4 S = (f32x4){0.f, 0.f, 0.f, 0.f};
            for (int c0 = 0; c0 < 64; c0 += 16) { f32x4 U[16], Dd[16];
#pragma unroll
                for (int s = 0; s < 16; ++s) { const int ci = b * 64 + c0 + s, item = ci * 4 + h; U[s] = *(const f32x4*)(UT + (size_t)item * 8192 + v * 64 + 4 * dq); Dd[s] = *(const f32x4*)(DEC + ci * 256 + h * 64 + 4 * dq); }
#pragma unroll
                for (int s = 0; s < 16; ++s) { const int item = (b * 64 + c0 + s) * 4 + h; u32x2 wv; wv.x = pk2(S[0], S[1]); wv.y = pk2(S[2], S[3]); *(u32x2*)(ST + (size_t)item * 8192 + v * 64 + 4 * dq) = wv; S = Dd[s] * (S + U[s]); } }
            float* o = p.out + O_GLAP + (size_t)((e * 4 + b) * 4 + h) * 8192 + (size_t)(4 * dq) * 128 + v;
#pragma unroll
            for (int k = 0; k < 4; ++k) o[k * 128] = S[k];
        } else { const int bs = bh - 16, b = bs >> 2, h = bs & 3, ci = 256 + b, item = ci * 4 + h;
            const float* s0 = p.in[3] + (size_t)((e * 8 + b) * 4 + h) * 8192 + (size_t)(4 * dq) * 128 + v;
            f32x4 S; S[0] = s0[0]; S[1] = s0[128]; S[2] = s0[256]; S[3] = s0[384];
            u32x2 wv; wv.x = pk2(S[0], S[1]); wv.y = pk2(S[2], S[3]); *(u32x2*)(ST + (size_t)item * 8192 + v * 64 + 4 * dq) = wv;
            const f32x4 U = *(const f32x4*)(UT + (size_t)item * 8192 + v * 64 + 4 * dq), Dd = *(const f32x4*)(DEC + ci * 256 + h * 64 + 4 * dq);
            S = Dd * (S + U);
            float* o = p.out + O_GLAS + (size_t)((e * 8 + b) * 4 + h) * 8192 + (size_t)(4 * dq) * 128 + v;
#pragma unroll
            for (int k = 0; k < 4; ++k) o[k * 128] = S[k];
        }
    }
}

__device__ __forceinline__ void gla_out(const Params& p, int e, LAS unsigned char* vimg, int gw, int NGW, int lane) {
    const bf16* proj = (const bf16*)(p.ws + W_PROJ); const bf16* QE = (const bf16*)(p.ws + W_QE); const bf16* KE = (const bf16*)(p.ws + W_KE); const bf16* ST = (const bf16*)(p.ws + W_ST);
    bf16* mix = (bf16*)(p.ws + W_MIX); const float* onorm = p.in[12] + e * 128;
    const int g = lane >> 4, l15 = lane & 15;
    for (int item = gw; item < NGLA; item += NGW) {
        const int ci = item >> 2, h = item & 3, row0 = ci * 64;
        CBAR();
#pragma unroll
        for (int it = 0; it < 16; ++it) { const int j = it * 4 + (lane >> 4), seg = lane & 15;
            *(LAS u32x4*)(vimg + j * 272 + seg * 16) = *(const u32x4*)(proj + (size_t)(row0 + j) * N_IN + C_V + h * 128 + seg * 8); }
        CBAR();
        const bf16* STi = ST + (size_t)item * 8192; const bf16* QEr = QE + (size_t)row0 * 256 + h * 64; const bf16* KEr = KE + (size_t)row0 * 256 + h * 64;
#pragma unroll 1
        for (int ih = 0; ih < 2; ++ih) {
            bf16x8 Bq[2][2];
#pragma unroll
            for (int ib = 0; ib < 2; ++ib)
#pragma unroll
                for (int ks = 0; ks < 2; ++ks) Bq[ib][ks] = *(const bf16x8*)(QEr + (size_t)(32 * ih + 16 * ib + l15) * 256 + 32 * ks + 8 * g);
            f32x4 att[4][2];
#pragma unroll
            for (int jb = 0; jb < 4; ++jb) {
                bf16x8 Ak[2];
#pragma unroll
                for (int ks = 0; ks < 2; ++ks) Ak[ks] = *(const bf16x8*)(KEr + (size_t)(16 * jb + l15) * 256 + 32 * ks + 8 * g);
#pragma unroll
                for (int ib = 0; ib < 2; ++ib) { f32x4 a = (f32x4){0.f, 0.f, 0.f, 0.f}; a = MFMA16(Ak[0], Bq[ib][0], a); a = MFMA16(Ak[1], Bq[ib][1], a);
                    const int i = 32 * ih + 16 * ib + l15, j0 = 16 * jb + 4 * g;
#pragma unroll
                    for (int r = 0; r < 4; ++r) if (j0 + r > i) a[r] = 0.f;
                    att[jb][ib] = a; }
            }
            bf16x8 Bp[2][2];
#pragma unroll
            for (int ib = 0; ib < 2; ++ib)
#pragma unroll
                for (int kk = 0; kk < 2; ++kk) Bp[ib][kk] = pack_frag(att[2 * kk][ib], att[2 * kk + 1][ib]);
            f32x4 o[8][2];
#pragma unroll
            for (int vb = 0; vb < 8; ++vb) {
                o[vb][0] = (f32x4){0.f, 0.f, 0.f, 0.f}; o[vb][1] = (f32x4){0.f, 0.f, 0.f, 0.f};
#pragma unroll
                for (int kk = 0; kk < 2; ++kk) { const bf16x8 A = frag_tr2(vimg, 272, 32 * kk, 32 * kk + 16, 16 * vb, lane); o[vb][0] = MFMA16(A, Bp[0][kk], o[vb][0]); o[vb][1] = MFMA16(A, Bp[1][kk], o[vb][1]); }
#pragma unroll
                for (int ks = 0; ks < 2; ++ks) { const bf16x8 A = *(const bf16x8*)(STi + (size_t)(16 * vb + l15) * 64 + 32 * ks + 8 * g); o[vb][0] = MFMA16(A, Bq[0][ks], o[vb][0]); o[vb][1] = MFMA16(A, Bq[1][ks], o[vb][1]); }
            }
#pragma unroll
            for (int ib = 0; ib < 2; ++ib) {
                float ss = 0.f;
#pragma unroll
                for (int vb = 0; vb < 8; ++vb) { const f32x4 x = o[vb][ib]; ss += (x[0] * x[0] + x[1] * x[1]) + (x[2] * x[2] + x[3] * x[3]); }
                ss += __shfl_xor(ss, 16); ss += __shfl_xor(ss, 32);
                const float rn = rsqrtf(ss * (1.0f / 128.0f) + 1e-6f);
                const int row = row0 + 32 * ih + 16 * ib + l15;
#pragma unroll
                for (int vb = 0; vb < 8; ++vb) { const int vv = 16 * vb + 4 * g; const f32x4 wn = *(const f32x4*)(onorm + vv);
                    const u32x2 gw2 = *(const u32x2*)(proj + (size_t)row * N_IN + C_G + h * 128 + vv);
                    const float g0 = bflo(gw2.x), g1 = bfhi(gw2.x), g2 = bflo(gw2.y), g3 = bfhi(gw2.y); const f32x4 x = o[vb][ib];
                    u32x2 w; w.x = pk2(x[0] * rn * wn[0] * silu_f(g0), x[1] * rn * wn[1] * silu_f(g1)); w.y = pk2(x[2] * rn * wn[2] * silu_f(g2), x[3] * rn * wn[3] * silu_f(g3));
                    *(u32x2*)(mix + (size_t)row * DM + 512 + h * 128 + vv) = w; }
            }
        }
    }
}

__device__ __forceinline__ void kv_src(const bf16* qkv, const bf16* ckb, int ci, int h, int m, const bf16*& kb, const bf16*& vb, int& pitch) {
    if (ci >= 256 && m > 0) { kb = ckb + ((size_t)(ci - 256) * 512 + (8 - m) * 64) * 1024 + h * 64; vb = kb + (size_t)8 * 512 * 1024; pitch = 1024; }
    else { kb = qkv + (size_t)(ci * 64 - 64 * m) * N_QKV + 1024 + h * 64; vb = kb + 1024; pitch = N_QKV; }
}
__device__ __forceinline__ void attn_item(const Params& p, int o, LAS unsigned char* vimg, LAS float* tbl, int item, float qkb, int lane) {
    const bf16* qkv = (const bf16*)(p.ws + W_PROJ); const bf16* ckb = (const bf16*)(p.ws + W_ST); bf16* mix = (bf16*)(p.ws + W_MIX);
    const int g = lane >> 4, l15 = lane & 15;
    constexpr float LOG2E = 1.4426950408889634f, C1 = 0.125f * LOG2E;
    const int ci = item >> 5, h = (item >> 1) & 15, ih = item & 1, row0 = ci * 64;
    const int nprev = ci >= 256 ? 8 : ((ci & 63) < 8 ? (ci & 63) : 8);
    CBAR();
    { const float* rb = p.in[17] + (size_t)(o * 16 + h) * 320; float bv[5]; float bm = -1e30f;
#pragma unroll
      for (int t = 0; t < 5; ++t) { bv[t] = rb[lane + 64 * t]; bm = fmaxf(bm, bv[t]); }
#pragma unroll
      for (int s = 1; s < 64; s <<= 1) bm = fmaxf(bm, __shfl_xor(bm, s));
      const float M = qkb + bm; const float last = (__builtin_bit_cast(float, __builtin_amdgcn_readlane(__builtin_bit_cast(int, bv[4]), 63)) - M) * LOG2E;
#pragma unroll
      for (int t = 0; t < 5; ++t) tbl[lane + 64 * t] = (bv[t] - M) * LOG2E;
#pragma unroll
      for (int t = 5; t < 10; ++t) tbl[lane + 64 * t] = last; }
    bf16x8 Bq[2][2];
#pragma unroll
    for (int ib = 0; ib < 2; ++ib)
#pragma unroll
        for (int ks = 0; ks < 2; ++ks) Bq[ib][ks] = *(const bf16x8*)(qkv + (size_t)(row0 + 32 * ih + 16 * ib + l15) * N_QKV + h * 64 + 32 * ks + 8 * g);
    f32x4 O[4][2]; float rsum[2] = {0.f, 0.f};
#pragma unroll
    for (int a = 0; a < 2; ++a)
#pragma unroll
        for (int b = 0; b < 4; ++b) O[b][a] = (f32x4){0.f, 0.f, 0.f, 0.f};
    bf16x8 Kn[4][2]; u32x4 Vn[8];
    const int vkey = lane >> 3, vseg = lane & 7;
    { const bf16* kb; const bf16* vb; int pitch; kv_src(qkv, ckb, ci, h, nprev, kb, vb, pitch);
#pragma unroll
      for (int it = 0; it < 8; ++it) Vn[it] = *(const u32x4*)(vb + (size_t)(it * 8 + vkey) * pitch + vseg * 8);
#pragma unroll
      for (int jb = 0; jb < 4; ++jb)
#pragma unroll
          for (int ks = 0; ks < 2; ++ks) Kn[jb][ks] = *(const bf16x8*)(kb + (size_t)(16 * jb + l15) * pitch + 32 * ks + 8 * g); }
#pragma unroll 1
    for (int m = nprev; m >= 0; --m) {
        bf16x8 Ak[4][2];
        CBAR();
#pragma unroll
        for (int it = 0; it < 8; ++it) *(LAS u32x4*)(vimg + (it * 8 + vkey) * 144 + vseg * 16) = Vn[it];
#pragma unroll
        for (int jb = 0; jb < 4; ++jb)
#pragma unroll
            for (int ks = 0; ks < 2; ++ks) Ak[jb][ks] = Kn[jb][ks];
        if (m > 0) { const bf16* kb; const bf16* vb; int pitch; kv_src(qkv, ckb, ci, h, m - 1, kb, vb, pitch);
#pragma unroll
            for (int it = 0; it < 8; ++it) Vn[it] = *(const u32x4*)(vb + (size_t)(it * 8 + vkey) * pitch + vseg * 8);
#pragma unroll
            for (int jb = 0; jb < 4; ++jb)
#pragma unroll
                for (int ks = 0; ks < 2; ++ks) Kn[jb][ks] = *(const bf16x8*)(kb + (size_t)(16 * jb + l15) * pitch + 32 * ks + 8 * g); }
        CBAR();
        const LAS float* tb = tbl + (64 * m + 32 * ih + l15 - 4 * g + 63 - 51);
        f32x4 s[4][2];
#pragma unroll
        for (int jb = 0; jb < 4; ++jb)
#pragma unroll
            for (int ib = 0; ib < 2; ++ib) { f32x4 a = (f32x4){0.f, 0.f, 0.f, 0.f}; a = MFMA16(Ak[jb][0], Bq[ib][0], a); a = MFMA16(Ak[jb][1], Bq[ib][1], a); s[jb][ib] = a; }
#pragma unroll
        for (int ib = 0; ib < 2; ++ib)
#pragma unroll
            for (int jb = 0; jb < 4; ++jb)
#pragma unroll
                for (int r = 0; r < 4; ++r) { const float pv = __builtin_amdgcn_exp2f(s[jb][ib][r] * C1 + tb[16 * ib - 16 * jb - r + 51]); s[jb][ib][r] = pv; rsum[ib] += pv; }
        bf16x8 Bp[2][2];
#pragma unroll
        for (int ib = 0; ib < 2; ++ib)
#pragma unroll
            for (int kk = 0; kk < 2; ++kk) Bp[ib][kk] = pack_frag(s[2 * kk][ib], s[2 * kk + 1][ib]);
#pragma unroll
        for (int db = 0; db < 4; ++db)
#pragma unroll
            for (int kk = 0; kk < 2; ++kk) { const bf16x8 A = frag_tr2(vimg, 144, 32 * kk, 32 * kk + 16, 16 * db, lane);
                O[db][0] = MFMA16(A, Bp[0][kk], O[db][0]); O[db][1] = MFMA16(A, Bp[1][kk], O[db][1]); }
    }
#pragma unroll
    for (int I = 0; I < 2; ++I) { float rs = rsum[I]; rs += __shfl_xor(rs, 16); rs += __shfl_xor(rs, 32); const float il = 1.0f / rs; const int row = row0 + 32 * ih + 16 * I + l15;
#pragma unroll
        for (int db = 0; db < 4; ++db) { const f32x4 x = O[db][I] * il; u32x2 w; w.x = pk2(x[0], x[1]); w.y = pk2(x[2], x[3]); *(u32x2*)(mix + (size_t)row * DM + h * 64 + 16 * db + 4 * g) = w; } }
}
__device__ __forceinline__ void cache_to_bf16(const Params& p, int o, int gtid, int NT) {
    constexpr int N8 = 8 * 512 * 1024 / 8;
    bf16* dst = (bf16*)(p.ws + W_ST);
    for (int i = gtid; i < 2 * N8; i += NT) { const int t = i / N8, j = i % N8; const float* s = p.in[4 + t] + (size_t)o * 8 * 512 * 1024 + (size_t)j * 8;
        const f32x4 a = *(const f32x4*)s, b = *(const f32x4*)(s + 4); u32x4 w; w.x = pk2(a[0], a[1]); w.y = pk2(a[2], a[3]); w.z = pk2(b[0], b[1]); w.w = pk2(b[2], b[3]);
        *(u32x4*)(dst + (size_t)t * 8 * 512 * 1024 + (size_t)j * 8) = w; }
}
__device__ __forceinline__ void attn_phase(const Params& p, int o, LAS unsigned char* wl, int gw, int NGW, int lane) {
    LAS unsigned char* vimg = wl; LAS float* tbl = (LAS float*)(wl + 64 * 144);
    float wmax = fabsf(p.in[15][o * 64 + lane]), kmax = fabsf(p.in[16][o * 64 + lane]);
#pragma unroll
    for (int s = 1; s < 64; s <<= 1) { wmax = fmaxf(wmax, __shfl_xor(wmax, s)); kmax = fmaxf(kmax, __shfl_xor(kmax, s)); }
    const float qkb = 8.0f * wmax * kmax;
    const int G = NGW >> 3, b = gw >> 3, w = gw & 7;
    const int x = b & 7, lw = (b >> 3) * 8 + w, nlw = ((G - x + 7) >> 3) * 8;
#pragma unroll 1
    for (int t = lw; t < NCHUNK * 4; t += nlw) {
        const int cidx = t >> 2, ci = cidx < 8 ? 256 + cidx : cidx - 8, item = (ci << 5) | ((2 * x + ((t >> 1) & 1)) << 1) | (t & 1);
        attn_item(p, o, vimg, tbl, item, qkb, lane);
    }
}

#define XB_TMO      128
#define XB_XCNT(j)  (256  + 64 * (j))
#define XB_XSUB(j)  (1280 + 64 * (j))
#define XB_XGEN(j)  (2304 + 64 * (j))
#define XB_TOP      3328
#define XB_TOPGEN   3392
#define XCD_BAR_WORDS 3456
#define XB_SPIN_CAP (1u << 18)

__device__ __forceinline__ unsigned xb_ld(unsigned* p)              { return __hip_atomic_load(p, __ATOMIC_RELAXED, __HIP_MEMORY_SCOPE_AGENT); }
__device__ __forceinline__ unsigned xb_add(unsigned* p, unsigned v) { return __hip_atomic_fetch_add(p, v, __ATOMIC_RELAXED, __HIP_MEMORY_SCOPE_AGENT); }
__device__ __forceinline__ unsigned xb_xcc_id() { return (unsigned)__builtin_amdgcn_s_getreg((3 << 11) | 20) & 0xFu; }
#define XB_SPIN(cond, bar) do { unsigned _sp = 0; while (cond) { __builtin_amdgcn_s_sleep(1); \
    if ((++_sp & 255u) == 0u) { if (xb_ld(&(bar)[XB_TMO])) break; if (_sp > XB_SPIN_CAP) { atomicAdd(&(bar)[XB_TMO], 1u); break; } } } } while (0)

struct XcdBarrier {
    unsigned* bar; unsigned x;
    volatile LAS unsigned* st;
};

__device__ __forceinline__ XcdBarrier xcd_barrier_post(unsigned* bar, volatile LAS unsigned* st) {
    XcdBarrier b; b.bar = bar; b.x = xb_xcc_id(); b.st = st;
    if (threadIdx.x == 0) (void)xb_add(&bar[XB_XCNT(b.x)], 1u);
    return b;
}
__device__ __forceinline__ void xcd_barrier_complete(unsigned* bar, unsigned x, unsigned& nloc, unsigned& nx) {
    const unsigned G = gridDim.x * gridDim.y * gridDim.z;
    unsigned sum, cnt, mine, sp = 0u;
    for (;;) {
        sum = 0u; cnt = 0u; mine = 0u;
#pragma unroll
        for (unsigned j = 0; j < 16; ++j) { const unsigned c = xb_ld(&bar[XB_XCNT(j)]); sum += c; cnt += (c > 0u) ? 1u : 0u; mine = (j == x) ? c : mine; }
        if (sum == G) break;
        __builtin_amdgcn_s_sleep(1);
        if ((++sp & 255u) == 0u) { if (xb_ld(&bar[XB_TMO])) break; if (sp > XB_SPIN_CAP) { atomicAdd(&bar[XB_TMO], 1u); break; } }
    }
    nloc = mine > 0u ? mine : 1u; nx = cnt > 0u ? cnt : 1u;
}

__device__ __forceinline__ void xcd_barrier(const XcdBarrier& b) {
    asm volatile("s_waitcnt vmcnt(0)" ::: "memory");
    __syncthreads();
    if (threadIdx.x == 0) {
        unsigned* bar = b.bar;
        __builtin_amdgcn_s_waitcnt(0);
        unsigned nloc = b.st[0], nx = b.st[1];
        if (nloc == 0u) { xcd_barrier_complete(bar, b.x, nloc, nx); b.st[0] = nloc; b.st[1] = nx; }
        const unsigned old = xb_add(&bar[XB_XSUB(b.x)], 1u);
        const unsigned gen = old / nloc;
        if (old + 1u == (gen + 1u) * nloc) {
            __builtin_amdgcn_fence(__ATOMIC_RELEASE, "agent");
            asm volatile("s_waitcnt vmcnt(0)" ::: "memory");
            const unsigned og = xb_add(&bar[XB_TOP], 1u);
            const unsigned tg = og / nx;
            if (og + 1u == (tg + 1u) * nx) xb_add(&bar[XB_TOPGEN], 1u);
            else XB_SPIN(xb_ld(&bar[XB_TOPGEN]) == tg, bar);
            __builtin_amdgcn_fence(__ATOMIC_ACQUIRE, "agent");
            xb_add(&bar[XB_XGEN(b.x)], 1u);
            asm volatile("s_waitcnt vmcnt(0)" ::: "memory");
        } else {
            XB_SPIN(xb_ld(&bar[XB_XGEN(b.x)]) == gen, bar);
            __builtin_amdgcn_fence(__ATOMIC_ACQUIRE, "agent");
            asm volatile("s_waitcnt vmcnt(0)" ::: "memory");
        }
    }
    __syncthreads();
}

#ifndef MK_SPLIT
#define MK_SPLIT 0
#endif
#ifndef PHMASK
#define PHMASK 0x7ff
#endif
#if MK_SPLIT
#define GRID_SYNC() do { } while (0)
#define PH(k) if (((PHMASK >> (k)) & 1) && ph == (k))
#else
#define COOP_SYNC() do { asm volatile("s_waitcnt vmcnt(0) lgkmcnt(0)" ::: "memory"); grid.sync(); __builtin_amdgcn_fence(__ATOMIC_ACQUIRE, "agent"); asm volatile("s_waitcnt vmcnt(0)" ::: "memory"); __syncthreads(); } while (0)
#define GRID_SYNC() xcd_barrier(bar)
#ifndef DUPMASK
#define DUPMASK 0
#endif
#ifndef EXTRA_SYNCS
#define EXTRA_SYNCS 0
#endif
#define PH(k) if constexpr ((((PHMASK) >> (k)) & 1) != 0) _Pragma("unroll 1") for (int rep_ = 0; rep_ < ((((DUPMASK) >> (k)) & 1) ? 2 : 1); ++rep_)
#endif

__global__ void __launch_bounds__(512) mega_fwd(Params p, int ph, int layer_arg) {
    extern __shared__ __attribute__((aligned(16))) unsigned char lds_raw[];
    LAS unsigned char* lds = (LAS unsigned char*)lds_raw;
#if !MK_SPLIT
    cg::grid_group grid = cg::this_grid();
#endif
    const int tid = threadIdx.x, lane = tid & 63, wave = __builtin_amdgcn_readfirstlane(tid >> 6), G = gridDim.x;
    const int gw = blockIdx.x * 8 + wave, NGW = G * 8, gtid = blockIdx.x * 512 + tid, NT = G * 512;
    LAS unsigned char* wl = lds + wave * WAVE_LDS;
    if (tid < 16) ((LAS unsigned*)(lds + LDS_CTL))[tid] = 0u;
    __syncthreads();
    XcdBarrier bar = xcd_barrier_post((unsigned*)(p.ws + W_BAR), (volatile LAS unsigned*)(lds + LDS_CTL));
    unsigned char* ws = p.ws;
    float* ssq = (float*)(ws + W_SSQ); bf16* xb = (bf16*)(ws + W_XB); bf16* proj = (bf16*)(ws + W_PROJ); bf16* mix = (bf16*)(ws + W_MIX);

#pragma unroll 1
    for (int xs_ = 0; xs_ < EXTRA_SYNCS; ++xs_) GRID_SYNC();
    PH(0) { prologue(p, lds, gw, NGW, OPQ((int)blockIdx.x * 512 + wave * 64 + LANE_NOW()), NT, wave, OPQ(LANE_NOW())); COOP_SYNC(); }
#if MK_SPLIT
    const int l_lo = layer_arg, l_hi = layer_arg + 1;
#else
    const int l_lo = 0, l_hi = 4;
#endif
#pragma unroll 1
    for (int layer = l_lo; layer < l_hi; ++layer) {
        const int e = layer >> 1;
        if ((layer & 1) == 0) {
            PH(1) { pg8::Gemm gm{xb, (const bf16*)(ws + W_IN) + (size_t)e * N_IN * 1024, TT, N_IN, 1024}; pg8::StaticOrder S; S.init(TT, N_IN, G, (int)blockIdx.x);
                pg8::EpiRowScale E{proj, N_IN, ssq + (size_t)(2 * layer) * TT * 16};
                pg8::gemm_phase<pg8::EpiRowScale, pg8::StaticOrder, true, true>(lds, gm, S, E); GRID_SYNC(); }
            PH(2) { gla_local(p, e, wl, gw, NGW, OPQ(LANE_NOW())); GRID_SYNC(); }
            PH(3) { gla_scan(p, e, OPQ((int)blockIdx.x * 512 + wave * 64 + LANE_NOW()), NT); GRID_SYNC(); }
            PH(4) { conv_phase(p, e, OPQ((int)blockIdx.x * 512 + wave * 64 + LANE_NOW()), NT); gla_out(p, e, wl, gw, NGW, OPQ(LANE_NOW())); GRID_SYNC(); }
            PH(5) { pg8::Gemm gm{mix, (const bf16*)(ws + W_OUT) + (size_t)e * 1024 * 1024, TT, 1024, 1024}; pg8::StaticOrder S; S.init(TT, 1024, G, (int)blockIdx.x);
                pg8::EpiResid E{p.out, xb, ssq + (size_t)(2 * layer + 1) * TT * 16};
                pg8::gemm_phase<pg8::EpiResid, pg8::StaticOrder, true, true>(lds, gm, S, E); GRID_SYNC(); }
        } else {
            PH(6) { cache_to_bf16(p, e, OPQ((int)blockIdx.x * 512 + wave * 64 + LANE_NOW()), NT);
                pg8::Gemm gm{xb, (const bf16*)(ws + W_QKV) + (size_t)e * N_QKV * 1024, TT, N_QKV, 1024}; pg8::StaticOrder S; S.init(TT, N_QKV, G, (int)blockIdx.x);
                pg8::EpiQKV E{proj, ssq + (size_t)(2 * layer) * TT * 16, p.in[15] + e * 64, p.in[16] + e * 64,
                              p.out + O_KP + (size_t)e * 4 * 512 * 1024, p.out + O_VP + (size_t)e * 4 * 512 * 1024, p.out + O_KS + (size_t)e * 8 * 512 * 1024, p.out + O_VS + (size_t)e * 8 * 512 * 1024};
                pg8::gemm_phase<pg8::EpiQKV, pg8::StaticOrder, true, true>(lds, gm, S, E); GRID_SYNC(); }
            PH(7) { attn_phase(p, e, wl, gw, NGW, OPQ(LANE_NOW())); GRID_SYNC(); }
            PH(8) { pg8::Gemm gm{mix, (const bf16*)(ws + W_O) + (size_t)e * 1024 * 1024, TT, 1024, 1024}; pg8::StaticOrder S; S.init(TT, 1024, G, (int)blockIdx.x);
                pg8::EpiResid E{p.out, xb, ssq + (size_t)(2 * layer + 1) * TT * 16};
                pg8::gemm_phase<pg8::EpiResid, pg8::StaticOrder, true, true>(lds, gm, S, E); GRID_SYNC(); }
        }
        PH(9) { pg8::Gemm gm{xb, (const bf16*)(ws + W_FFI) + (size_t)layer * N_FF2 * 1024, TT, N_FF2, 1024}; pg8::StaticOrder S; S.init(TT, N_FF2, G, (int)blockIdx.x);
            pg8::EpiSwiGLU E{proj, ssq + (size_t)(2 * layer + 1) * TT * 16};
            pg8::gemm_phase<pg8::EpiSwiGLU, pg8::StaticOrder, true, true>(lds, gm, S, E); GRID_SYNC(); }
        PH(10) { pg8::Gemm gm{proj, (const bf16*)(ws + W_FFO) + (size_t)layer * 1024 * DFF, TT, 1024, DFF}; pg8::StaticOrder S; S.init(TT, 1024, G, (int)blockIdx.x);
            pg8::EpiResid E{p.out, xb, ssq + (size_t)(2 * layer + 2) * TT * 16};
            pg8::gemm_phase<pg8::EpiResid, pg8::StaticOrder, true, true>(lds, gm, S, E);
            if (layer < 3) GRID_SYNC(); }
    }
}

extern "C" void kernel_launch(void* const* d_in, const int* in_sizes, int n_in, void* d_out, int out_size, void* d_ws, size_t ws_size, hipStream_t stream) {
    static int grid = 0;
    if (grid == 0) {
        if (n_in != 21 || (size_t)out_size != O_END || ws_size < W_END) { fprintf(stderr, "kernel_launch: unexpected shapes (n_in %d, out %d, ws %zu, need %zu)\n", n_in, out_size, ws_size, (size_t)W_END); grid = -1; return; }
        int dev = 0, cus = 0, per_cu = 0;
        hipGetDevice(&dev); hipDeviceGetAttribute(&cus, hipDeviceAttributeMultiprocessorCount, dev);
        if (hipFuncSetAttribute((const void*)mega_fwd, hipFuncAttributeMaxDynamicSharedMemorySize, LDS_BYTES) != hipSuccess) { fprintf(stderr, "kernel_launch: hipFuncSetAttribute failed\n"); grid = -1; return; }
        if (hipOccupancyMaxActiveBlocksPerMultiprocessor(&per_cu, (const void*)mega_fwd, 512, LDS_BYTES) != hipSuccess || per_cu < 1) { fprintf(stderr, "kernel_launch: occupancy query says %d\n", per_cu); (void)hipGetLastError(); per_cu = 1; }
        grid = cus * per_cu;
    }
    if (grid < 0) return;
    Params p{};
    for (int i = 0; i < 21; ++i) p.in[i] = (const float*)d_in[i];
    p.out = (float*)d_out; p.ws = (unsigned char*)d_ws;
#if MK_SPLIT
    hipLaunchKernelGGL(mega_fwd, dim3(grid), dim3(512), LDS_BYTES, stream, p, 0, 0);
    for (int layer = 0; layer < 4; ++layer) {
        if ((layer & 1) == 0) { for (int ph = 1; ph <= 5; ++ph) hipLaunchKernelGGL(mega_fwd, dim3(grid), dim3(512), LDS_BYTES, stream, p, ph, layer); }
        else { for (int ph = 6; ph <= 8; ++ph) hipLaunchKernelGGL(mega_fwd, dim3(grid), dim3(512), LDS_BYTES, stream, p, ph, layer); }
        for (int ph = 9; ph <= 10; ++ph) hipLaunchKernelGGL(mega_fwd, dim3(grid), dim3(512), LDS_BYTES, stream, p, ph, layer);
    }
#else
    if (hipMemsetAsync((char*)d_ws + W_BAR, 0, 16384, stream) != hipSuccess) { fprintf(stderr, "kernel_launch: memset failed\n"); return; }
    int ph = -1, la = 0;
    void* args[] = {&p, &ph, &la};
    hipError_t err = hipLaunchCooperativeKernel((const void*)mega_fwd, dim3(grid), dim3(512), args, LDS_BYTES, stream);
    if (err != hipSuccess) fprintf(stderr, "kernel_launch: cooperative launch failed: %s (grid %d)\n", hipGetErrorString(err), grid);
#endif
}
```

```cpp
#include <hip/hip_runtime.h>
#include <hip/hip_cooperative_groups.h>
#include <cstdio>
#include <cstdint>
namespace cg = cooperative_groups;
namespace pg8 {
#define PG8_LAS __attribute__((address_space(3)))
typedef unsigned short bf16_t;
typedef short bf16x8 __attribute__((ext_vector_type(8)));
typedef float f32x4 __attribute__((ext_vector_type(4)));
typedef unsigned u32x4 __attribute__((ext_vector_type(4)));
constexpr int BM = 256, BK = 64, HALF = 128, HTB = HALF * BK * 2  , STAGE_BYTES = 8 * HTB, NXCD = 8, WGM = 8;

__host__ __device__ __forceinline__ int lds_byte(int r, int c) { const int st = (r >> 4) * 2 + (c >> 5), rr = r & 15, cc = c & 31, ob = rr * 64 + cc * 2; return st * 1024 + (ob ^ (((ob >> 9) & 1) << 5)); }
__host__ __device__ __forceinline__ void stage_rc(int b, int& R, int& C) { const int st = b / 1024, sb = b % 1024, swz = sb ^ (((sb >> 9) & 1) << 5); R = (st >> 1) * 16 + swz / 64; C = (st & 1) * 32 + (swz % 64) / 2; }
__host__ __device__ __forceinline__ int perm32(int rho) { const int n = rho >> 4, i = rho & 15; return 8 * (i >> 2) + 4 * n + (i & 3); }

struct Unit { int pm, pn; };
struct Gemm { const bf16_t* A; const bf16_t* Bt; int M, N, K; };

struct StaticOrder {
    int nM, nN, nwg, G, c;
    __host__ __device__ void init(int M, int N, int G_, int c_) { nM = M / BM; nN = N / BM; nwg = nM * nN; G = G_; c = c_; }
    __host__ __device__ bool next(int i, Unit& u) const {
        const long L = (long)i * G + c; if (L >= nwg) return false;
        int wgid = (int)L; { const int q = nwg / NXCD, r = nwg % NXCD, xcd = wgid % NXCD, off = wgid / NXCD; wgid = (xcd < r ? xcd * (q + 1) : r * (q + 1) + (xcd - r) * q) + off; }
        const int nig = WGM * nN, gid = wgid / nig, fm = gid * WGM, gsz = (nM - fm) < WGM ? (nM - fm) : WGM;
        u.pm = fm + ((wgid % nig) % gsz); u.pn = (wgid % nig) / gsz; return true;
    }
    __device__ __forceinline__ void a_ready(const Unit&) const {}
    __device__ __forceinline__ void done(const Unit&) const {}
};
__device__ __forceinline__ unsigned cvt_pk_bf16(float lo, float hi) { unsigned r; asm volatile("v_cvt_pk_bf16_f32 %0, %1, %2" : "=v"(r) : "v"(lo), "v"(hi)); return r; }
typedef float f32x2 __attribute__((ext_vector_type(2)));
__device__ __forceinline__ float rinv_of(const float* ssq, int row) { const f32x4* q = (const f32x4*)(ssq + (size_t)row * 16); const f32x4 a = q[0], b = q[1], c = q[2], d = q[3];
    const f32x4 s = (a + b) + (c + d); return rsqrtf(((s[0] + s[1]) + (s[2] + s[3])) * (1.0f / 1024.0f) + 1e-6f); }
__device__ __forceinline__ u32x4 pack8(const f32x4& a, const f32x4& b) { u32x4 w; w.x = cvt_pk_bf16(a[0], a[1]); w.y = cvt_pk_bf16(a[2], a[3]); w.z = cvt_pk_bf16(b[0], b[1]); w.w = cvt_pk_bf16(b[2], b[3]); return w; }

__device__ __forceinline__ void acc_zero(f32x4 (&acc)[2][2][4][2]) {
#pragma unroll
    for (int a = 0; a < 2; ++a)
#pragma unroll
        for (int b = 0; b < 2; ++b)
#pragma unroll
            for (int m = 0; m < 4; ++m)
#pragma unroll
                for (int n = 0; n < 2; ++n) acc[a][b][m][n] = (f32x4){0.f, 0.f, 0.f, 0.f};
}
struct EpiRowScale {
    static constexpr bool PERM = true, AFTER_DRAIN = false;
    bf16_t* O; int ldc; const float* ssq;
    __device__ __forceinline__ void init(f32x4 (&acc)[2][2][4][2], const Unit&, int, int, int, int) const { acc_zero(acc); }
    __device__ __forceinline__ void operator()(const f32x4 (&acc)[2][2][4][2], const Unit& u, int wr, int wc, int fr, int fq) const {
        const int row0 = u.pm * BM + wr * 64 + fr, col0 = u.pn * BM + wc * 32 + 8 * fq;
        float ri8[2][4];
#pragma unroll
        for (int ai = 0; ai < 2; ++ai)
#pragma unroll
            for (int m = 0; m < 4; ++m) ri8[ai][m] = rinv_of(ssq, row0 + ai * HALF + m * 16);
#pragma unroll
        for (int ai = 0; ai < 2; ++ai)
#pragma unroll
            for (int m = 0; m < 4; ++m) { const int row = row0 + ai * HALF + m * 16; const float ri = ri8[ai][m]; bf16_t* rowp = O + (size_t)row * ldc + col0;
#pragma unroll
                for (int bj = 0; bj < 2; ++bj) { const f32x4 v0 = acc[ai][bj][m][0] * ri, v1 = acc[ai][bj][m][1] * ri; *(u32x4*)(rowp + bj * HALF) = pack8(v0, v1); } }
    }
};

struct EpiQKV {
    static constexpr bool PERM = true, AFTER_DRAIN = false;
    bf16_t* O; const float* ssq; const float* qn; const float* kn; float* kp; float* vp; float* ks; float* vs;
    __device__ __forceinline__ void init(f32x4 (&acc)[2][2][4][2], const Unit&, int, int, int, int) const { acc_zero(acc); }
    __device__ __forceinline__ void operator()(const f32x4 (&acc)[2][2][4][2], const Unit& u, int wr, int wc, int fr, int fq) const {
        const int t = u.pn >> 2;
        const int row0 = u.pm * BM + wr * 64 + fr, lcol0 = u.pn * BM + wc * 64 + 8 * fq;
        const float* wsrc = (t == 0 ? qn : kn) + 8 * fq;
#pragma unroll
        for (int ai = 0; ai < 2; ++ai) { float ri4[4];
#pragma unroll
            for (int m = 0; m < 4; ++m) ri4[m] = rinv_of(ssq, row0 + ai * HALF + m * 16);
#pragma unroll
            for (int m = 0; m < 4; ++m) { const int row = row0 + ai * HALF + m * 16; const float ri = ri4[m];
                f32x4 v[2][2]; float ss = 0.f;
#pragma unroll
                for (int bj = 0; bj < 2; ++bj)
#pragma unroll
                    for (int n = 0; n < 2; ++n) { v[bj][n] = acc[ai][bj][m][n] * ri; const f32x4 x = v[bj][n]; ss += (x[0] * x[0] + x[1] * x[1]) + (x[2] * x[2] + x[3] * x[3]); }
                if (t < 2) { ss += __shfl_xor(ss, 16); ss += __shfl_xor(ss, 32); const float r2 = rsqrtf(ss * (1.0f / 64.0f) + 1e-6f);
#pragma unroll
                    for (int bj = 0; bj < 2; ++bj)
#pragma unroll
                        for (int n = 0; n < 2; ++n) v[bj][n] = v[bj][n] * r2 * *(const f32x4*)(wsrc + 32 * bj + 4 * n); }
                bf16_t* rowp = O + (size_t)row * 3072 + lcol0;
#pragma unroll
                for (int bj = 0; bj < 2; ++bj) *(u32x4*)(rowp + 32 * bj) = pack8(v[bj][0], v[bj][1]);
                if (t >= 1) { float* dst = nullptr;
                    if (row < 16384) { const int b = row >> 12, tt = row & 4095; if (tt >= 3584) dst = (t == 1 ? kp : vp) + ((size_t)(b * 512 + tt - 3584) * 1024); }
                    else { const int rs = row - 16384, b = rs >> 6, tt = rs & 63; dst = (t == 1 ? ks : vs) + ((size_t)(b * 512 + 448 + tt) * 1024); }
                    if (dst) { dst += (lcol0 & 1023);
#pragma unroll
                        for (int bj = 0; bj < 2; ++bj) { *(f32x4*)(dst + 32 * bj) = v[bj][0]; *(f32x4*)(dst + 32 * bj + 4) = v[bj][1]; } } }
            } }
    }
};

struct EpiResid {
    static constexpr bool PERM = false, AFTER_DRAIN = false;
    float* Y; bf16_t* XB; float* ssq_next;
    __device__ __forceinline__ void init(f32x4 (&acc)[2][2][4][2], const Unit& u, int wr, int wc, int fr, int fq) const {
        typedef unsigned u32x2 __attribute__((ext_vector_type(2)));
        const int row0 = u.pm * BM + wr * 64 + fr, col0 = u.pn * BM + wc * 32 + 4 * fq;
#pragma unroll
        for (int ai = 0; ai < 2; ++ai)
#pragma unroll
            for (int m = 0; m < 4; ++m) { const bf16_t* br = XB + (size_t)(row0 + ai * HALF + m * 16) * 1024 + col0;
#pragma unroll
                for (int bj = 0; bj < 2; ++bj)
#pragma unroll
                    for (int n = 0; n < 2; ++n) { const u32x2 w = *(const u32x2*)(br + bj * HALF + n * 16);
                        acc[ai][bj][m][n] = (f32x4){__uint_as_float(w.x << 16), __uint_as_float(w.x & 0xffff0000u), __uint_as_float(w.y << 16), __uint_as_float(w.y & 0xffff0000u)}; } }
    }
    __device__ __forceinline__ void operator()(const f32x4 (&acc)[2][2][4][2], const Unit& u, int wr, int wc, int fr, int fq) const {
        typedef unsigned u32x2 __attribute__((ext_vector_type(2)));
        const int row0 = u.pm * BM + wr * 64 + fr, col0 = u.pn * BM + wc * 32 + 4 * fq;
#pragma unroll
        for (int ai = 0; ai < 2; ++ai)
#pragma unroll
            for (int m = 0; m < 4; ++m) { const int row = row0 + ai * HALF + m * 16; bf16_t* br = XB + (size_t)row * 1024 + col0; float ss = 0.f;
#pragma unroll
                for (int bj = 0; bj < 2; ++bj)
#pragma unroll
                    for (int n = 0; n < 2; ++n) { const f32x4 x = acc[ai][bj][m][n]; if (Y) *(f32x4*)(Y + (size_t)row * 1024 + col0 + bj * HALF + n * 16) = x;
                        ss += (x[0] * x[0] + x[1] * x[1]) + (x[2] * x[2] + x[3] * x[3]); u32x2 w; w.x = cvt_pk_bf16(x[0], x[1]); w.y = cvt_pk_bf16(x[2], x[3]); *(u32x2*)(br + bj * HALF + n * 16) = w; }
                ss += __shfl_xor(ss, 16); ss += __shfl_xor(ss, 32);
                if (fq == 0) ssq_next[(size_t)row * 16 + u.pn * 4 + wc] = ss; }
    }
};

struct EpiSwiGLU {
    static constexpr bool PERM = true, AFTER_DRAIN = false;
    bf16_t* H; const float* ssq;
    __device__ __forceinline__ void init(f32x4 (&acc)[2][2][4][2], const Unit&, int, int, int, int) const { acc_zero(acc); }
    __device__ __forceinline__ void operator()(const f32x4 (&acc)[2][2][4][2], const Unit& u, int wr, int wc, int fr, int fq) const {
        const int row0 = u.pm * BM + wr * 64 + fr, col0 = u.pn * HALF + wc * 32 + 8 * fq;
        float ri8[2][4];
#pragma unroll
        for (int ai = 0; ai < 2; ++ai)
#pragma unroll
            for (int m = 0; m < 4; ++m) ri8[ai][m] = rinv_of(ssq, row0 + ai * HALF + m * 16);
#pragma unroll
        for (int ai = 0; ai < 2; ++ai)
#pragma unroll
            for (int m = 0; m < 4; ++m) { const int row = row0 + ai * HALF + m * 16; const float ri = ri8[ai][m]; f32x4 h[2];
#pragma unroll
                for (int n = 0; n < 2; ++n) { const f32x4 g = acc[ai][0][m][n] * ri, up = acc[ai][1][m][n] * ri;
#pragma unroll
                    for (int j = 0; j < 4; ++j) h[n][j] = g[j] * __builtin_amdgcn_rcpf(1.0f + __expf(-g[j])) * up[j]; }
                *(u32x4*)(H + (size_t)row * 2816 + col0) = pack8(h[0], h[1]); }
    }
};

template <class Epi, class Sched, bool ALIGN_EPI = false, bool SP2 = false>
__device__ __forceinline__ void gemm_phase(PG8_LAS unsigned char* lds, const Gemm g, const Sched& S, const Epi& E) {
    int tid_; asm volatile("v_mbcnt_lo_u32_b32 %0, -1, 0\n\tv_mbcnt_hi_u32_b32 %0, -1, %0" : "=v"(tid_)); tid_ += __builtin_amdgcn_readfirstlane(threadIdx.x >> 6) * 64;
    const int tid = tid_, wid = __builtin_amdgcn_readfirstlane(tid >> 6), lane = tid & 63, wr = wid >> 2, wc = wid & 3, fr = lane & 15, fq = lane >> 4;
    const int K = g.K, nt = K / BK;
    unsigned voffA[2], voffB[2];
#pragma unroll
    for (int i = 0; i < 2; ++i) { int R, C; stage_rc(tid * 16 + i * 8192, R, C); const int Rb = Epi::PERM ? ((R & ~31) + perm32(R & 31)) : R;
        voffA[i] = (unsigned)(R * K + C) * 2u; voffB[i] = (unsigned)(Rb * K + C) * 2u; }
    const size_t kstep = (size_t)(BK * 2);
    const size_t hstep = (size_t)HALF * K * 2;
    const size_t tstep = 2 * hstep;
    const unsigned ldsw = (unsigned)wid * 1024u;
    const int aoff = lds_byte(wr * 64 + fr, fq * 8), boff = lds_byte(wc * 32 + fr, fq * 8);
#define PG8_SA(b, h) (((b) * 2 + (h)) * HTB)
#define PG8_SB(b, h) ((4 + (b) * 2 + (h)) * HTB)
#define PG8_STAGE(bufoff, gbase, voff) do { _Pragma("unroll") for (int _i = 0; _i < 2; ++_i) \
        __builtin_amdgcn_global_load_lds((const unsigned*)((const char*)(gbase) + (voff)[_i]), (PG8_LAS unsigned*)(lds + (bufoff) + ldsw + _i * 8192), 16, 0, 0); } while (0)
#define PG8_LDA(dst, b, h) do { _Pragma("unroll") for (int m = 0; m < 4; ++m) _Pragma("unroll") for (int k = 0; k < 2; ++k) dst[m][k] = *(const PG8_LAS bf16x8*)(lds + PG8_SA(b, h) + aoff + m * 2048 + k * 1024); } while (0)
#define PG8_LDB(dst, b, h) do { _Pragma("unroll") for (int n = 0; n < 2; ++n) _Pragma("unroll") for (int k = 0; k < 2; ++k) dst[n][k] = *(const PG8_LAS bf16x8*)(lds + PG8_SB(b, h) + boff + n * 2048 + k * 1024); } while (0)
#define PG8_MMA(ai, bj, At, Bt) do { __builtin_amdgcn_s_setprio(1); _Pragma("unroll") for (int m = 0; m < 4; ++m) _Pragma("unroll") for (int n = 0; n < 2; ++n) _Pragma("unroll") for (int k = 0; k < 2; ++k) \
        acc[ai][bj][m][n] = __builtin_amdgcn_mfma_f32_16x16x32_bf16(Bt[n][k], At[m][k], acc[ai][bj][m][n], 0, 0, 0); __builtin_amdgcn_s_setprio(0); } while (0)
#define PG8_WAIT_V(n) asm volatile("s_waitcnt vmcnt(" #n ")" ::: "memory")
#define PG8_WAIT_L(n) asm volatile("s_waitcnt lgkmcnt(" #n ")" ::: "memory")
#define PG8_BAR __builtin_amdgcn_s_barrier()
#define PG8_SCHED __builtin_amdgcn_sched_barrier(0)
    Unit cur, nxt; int ui = 0;
    if (!S.next(0, cur)) return;
    f32x4 acc[2][2][4][2];
    E.init(acc, cur, wr, wc, fr, fq);
    bf16x8 At[4][2], B0[2][2], B1[2][2];
    const char* cA = (const char*)g.A + (size_t)cur.pm * tstep; const char* cB = (const char*)g.Bt + (size_t)cur.pn * tstep;
    S.a_ready(cur);
    if constexpr (SP2) {
        PG8_STAGE(PG8_SB(0, 0), cB, voffB); PG8_STAGE(PG8_SB(0, 1), cB + hstep, voffB); PG8_STAGE(PG8_SA(0, 0), cA, voffA); PG8_STAGE(PG8_SA(0, 1), cA + hstep, voffA);
        if (wr == 1) PG8_BAR;
        PG8_WAIT_V(2); PG8_BAR;
        PG8_STAGE(PG8_SB(1, 0), cB + kstep, voffB); PG8_STAGE(PG8_SA(1, 0), cA + kstep, voffA); PG8_STAGE(PG8_SB(1, 1), cB + hstep + kstep, voffB);
        PG8_WAIT_V(6); PG8_BAR;
    } else {
        PG8_STAGE(PG8_SB(0, 0), cB, voffB); PG8_STAGE(PG8_SA(0, 0), cA, voffA); PG8_STAGE(PG8_SB(0, 1), cB + hstep, voffB); PG8_STAGE(PG8_SA(0, 1), cA + hstep, voffA);
        if (wr == 1) PG8_BAR;
        PG8_WAIT_V(4); PG8_BAR;
        PG8_STAGE(PG8_SB(1, 0), cB + kstep, voffB); PG8_STAGE(PG8_SA(1, 0), cA + kstep, voffA); PG8_STAGE(PG8_SB(1, 1), cB + hstep + kstep, voffB);
        PG8_WAIT_V(6); PG8_BAR;
    }
    for (;;) {
        const bool has_next = S.next(ui + 1, nxt);
        const char* nA = has_next ? (const char*)g.A + (size_t)nxt.pm * tstep : cA; const char* nB = has_next ? (const char*)g.Bt + (size_t)nxt.pn * tstep : cB;
        for (int t = 0; t < nt; t += 2) {
            const bool last = (t == nt - 2);
            const char* a1 = cA + (size_t)(t + 1) * kstep;
            const char* a2 = last ? nA : cA + (size_t)(t + 2) * kstep; const char* b2 = last ? nB : cB + (size_t)(t + 2) * kstep;
            const char* a3 = a2 + kstep; const char* b3 = b2 + kstep;
            if (last && has_next) S.a_ready(nxt);
            if constexpr (SP2) {
            PG8_LDB(B0, 0, 0); PG8_LDB(B1, 0, 1); PG8_SCHED; PG8_LDA(At, 0, 0); PG8_STAGE(PG8_SA(1, 1), a1 + hstep, voffA);
            PG8_WAIT_V(8); PG8_WAIT_L(0); PG8_BAR; PG8_MMA(0, 0, At, B0); PG8_MMA(0, 1, At, B1); PG8_BAR; PG8_SCHED;
            PG8_LDA(At, 0, 1); PG8_STAGE(PG8_SB(0, 0), b2, voffB); PG8_STAGE(PG8_SB(0, 1), b2 + hstep, voffB); PG8_STAGE(PG8_SA(0, 0), a2, voffA);
            PG8_WAIT_V(8); PG8_WAIT_L(0); PG8_BAR; PG8_MMA(1, 0, At, B0); PG8_MMA(1, 1, At, B1); PG8_BAR; PG8_SCHED;
            PG8_LDB(B0, 1, 0); PG8_LDB(B1, 1, 1); PG8_SCHED; PG8_LDA(At, 1, 0); PG8_STAGE(PG8_SA(0, 1), a2 + hstep, voffA);
            PG8_WAIT_V(8); PG8_WAIT_L(0); PG8_BAR; PG8_MMA(0, 0, At, B0); PG8_MMA(0, 1, At, B1); PG8_BAR; PG8_SCHED;
            PG8_LDA(At, 1, 1); PG8_STAGE(PG8_SB(1, 0), b3, voffB); PG8_STAGE(PG8_SB(1, 1), b3 + hstep, voffB); PG8_STAGE(PG8_SA(1, 0), a3, voffA);
            PG8_WAIT_V(8); PG8_WAIT_L(0); PG8_BAR; PG8_MMA(1, 0, At, B0); PG8_MMA(1, 1, At, B1); PG8_BAR; PG8_SCHED;
            } else {
            PG8_LDB(B0, 0, 0); PG8_SCHED; PG8_LDA(At, 0, 0); PG8_STAGE(PG8_SA(1, 1), a1 + hstep, voffA);
            PG8_WAIT_L(8); PG8_BAR; PG8_WAIT_L(0); PG8_MMA(0, 0, At, B0); PG8_BAR; PG8_SCHED;
            PG8_LDB(B1, 0, 1); PG8_STAGE(PG8_SB(0, 0), b2, voffB);
            PG8_BAR; PG8_WAIT_L(0); PG8_MMA(0, 1, At, B1); PG8_BAR;
            PG8_LDA(At, 0, 1); PG8_STAGE(PG8_SA(0, 0), a2, voffA);
            PG8_BAR; PG8_WAIT_L(0); PG8_MMA(1, 0, At, B0); PG8_BAR; PG8_SCHED;
            PG8_STAGE(PG8_SB(0, 1), b2 + hstep, voffB);
            PG8_WAIT_V(6); PG8_BAR; PG8_MMA(1, 1, At, B1); PG8_BAR;
            PG8_LDB(B0, 1, 0); PG8_SCHED; PG8_LDA(At, 1, 0); PG8_STAGE(PG8_SA(0, 1), a2 + hstep, voffA);
            PG8_WAIT_L(8); PG8_BAR; PG8_WAIT_L(0); PG8_MMA(0, 0, At, B0); PG8_BAR; PG8_SCHED;
            PG8_LDB(B1, 1, 1); PG8_STAGE(PG8_SB(1, 0), b3, voffB);
            PG8_BAR; PG8_WAIT_L(0); PG8_MMA(0, 1, At, B1); PG8_BAR;
            PG8_LDA(At, 1, 1); PG8_STAGE(PG8_SA(1, 0), a3, voffA);
            PG8_BAR; PG8_WAIT_L(0); PG8_MMA(1, 0, At, B0); PG8_BAR; PG8_SCHED;
            PG8_STAGE(PG8_SB(1, 1), b3 + hstep, voffB);
            PG8_WAIT_V(6); PG8_BAR; PG8_MMA(1, 1, At, B1); PG8_BAR;
            }
        }
        if constexpr (ALIGN_EPI) { if (wr == 0) PG8_BAR; }
        if constexpr (!Epi::AFTER_DRAIN) { E(acc, cur, wr, wc, fr, fq); S.done(cur); }
        if (!has_next) break;
        E.init(acc, nxt, wr, wc, fr, fq);
        cur = nxt; cA = nA; cB = nB; ++ui;
        if constexpr (ALIGN_EPI) { if (wr == 1) PG8_BAR; }
    }
    PG8_WAIT_V(0);
    if constexpr (!ALIGN_EPI) { if (wr == 0) PG8_BAR; }
    PG8_BAR;
    if constexpr (Epi::AFTER_DRAIN) { E.fused(acc, cur, wr, wc, fr, fq, lds, wid, lane); S.done(cur); }
#undef PG8_SA
#undef PG8_SB
#undef PG8_STAGE
#undef PG8_LDA
#undef PG8_LDB
#undef PG8_MMA
#undef PG8_WAIT_V
#undef PG8_WAIT_L
#undef PG8_BAR
#undef PG8_SCHED
}
}

#define LAS __attribute__((address_space(3)))
typedef unsigned short bf16;
typedef float f32x4 __attribute__((ext_vector_type(4)));
typedef unsigned u32x4 __attribute__((ext_vector_type(4)));
typedef unsigned u32x2 __attribute__((ext_vector_type(2)));
typedef short bf16x8 __attribute__((ext_vector_type(8)));
typedef short s16x4 __attribute__((ext_vector_type(4)));

constexpr int DM = 1024, TP = 16384, TS = 512, TT = TP + TS, NCHUNK = TT / 64;
constexpr int N_IN = 3328, N_IN_SRC = 3088, N_QKV = 3072, N_FF2 = 5632, DFF = 2816;
constexpr int C_CG = 0, C_BG = 512, C_HC = 1024, C_Q = 1536, C_K = 1792, C_V = 2048, C_G = 2560, C_GK = 3072;
constexpr int NGLA = NCHUNK * 4;
constexpr int NATT = NCHUNK * 16;
constexpr size_t O_YP = 0, O_CONVP = (size_t)TT * DM, O_GLAP = O_CONVP + 2 * 4 * 2 * 512, O_KP = O_GLAP + 2 * 4 * 4 * 64 * 128, O_VP = O_KP + (size_t)2 * 4 * 512 * 1024,
                 O_CONVS = O_VP + (size_t)2 * 4 * 512 * 1024, O_GLAS = O_CONVS + 2 * 8 * 2 * 512, O_KS = O_GLAS + 2 * 8 * 4 * 64 * 128, O_VS = O_KS + (size_t)2 * 8 * 512 * 1024, O_END = O_VS + (size_t)2 * 8 * 512 * 1024;
static_assert(O_END == 43278336, "output size");
constexpr size_t W_IN = 0, W_QKV = W_IN + (size_t)2 * N_IN * 1024 * 2, W_FFI = W_QKV + (size_t)2 * N_QKV * 1024 * 2, W_FFO = W_FFI + (size_t)4 * N_FF2 * 1024 * 2, W_OUT = W_FFO + (size_t)4 * 1024 * DFF * 2,
                 W_O = W_OUT + (size_t)2 * 1024 * 1024 * 2, W_XB = W_O + (size_t)2 * 1024 * 1024 * 2, W_PROJ = W_XB + (size_t)TT * 1024 * 2, W_MIX = W_PROJ + (size_t)TT * N_IN * 2,
                 W_ST = W_MIX + (size_t)TT * 1024 * 2, W_QE = W_ST + (size_t)NGLA * 8192 * 2, W_KE = W_QE + (size_t)TT * 256 * 2, W_DEC = W_KE + (size_t)TT * 256 * 2, W_SSQ = W_DEC + (size_t)NCHUNK * 256 * 4,
                 W_BAR = W_SSQ + (size_t)9 * TT * 16 * 4, W_END = W_BAR + 16384;
static_assert((size_t)NGLA * 8192 * 4 == (size_t)TT * 1024 * 2, "UT overlays MIX");
constexpr int WAVE_LDS = 18432, LDS_CTL = 8 * WAVE_LDS, LDS_BYTES = LDS_CTL + 64;
static_assert(LDS_BYTES >= pg8::STAGE_BYTES, "lds");

struct Params { const float* in[21]; float* out; unsigned char* ws; };

__device__ __forceinline__ float bf2f(unsigned short b) { return __uint_as_float(((unsigned)b) << 16); }
__device__ __forceinline__ float bflo(unsigned w) { return __uint_as_float(w << 16); }
__device__ __forceinline__ float bfhi(unsigned w) { return __uint_as_float(w & 0xffff0000u); }
__device__ __forceinline__ unsigned pk2(float lo, float hi) { return pg8::cvt_pk_bf16(lo, hi); }
__device__ __forceinline__ unsigned short f2bf(float f) { return (unsigned short)(pk2(f, 0.f) & 0xffffu); }
__device__ __forceinline__ float wave_sum(float v) {
#pragma unroll
    for (int o = 1; o < 64; o <<= 1) v += __shfl_xor(v, o);
    return v;
}
__device__ __forceinline__ float silu_f(float g) { return g * __builtin_amdgcn_rcpf(1.0f + __expf(-g)); }
#define CBAR() asm volatile("" ::: "memory")
#define OPQ(x) ({ int _t = (x); asm volatile("" : "+v"(_t)); _t; })
#define LANE_NOW() ({ int _l; asm volatile("v_mbcnt_lo_u32_b32 %0, -1, 0\n\tv_mbcnt_hi_u32_b32 %0, -1, %0" : "=v"(_l)); _l; })
#define LDS_WAIT() asm volatile("s_waitcnt lgkmcnt(0)" ::: "memory")
__device__ __forceinline__ s16x4 tr4(LAS const unsigned char* p) { return __builtin_bit_cast(s16x4, __builtin_amdgcn_ds_read_tr16_b64_v4i16((LAS s16x4*)p)); }
__device__ __forceinline__ bf16x8 frag_tr2(LAS const unsigned char* img, int stride, int rlo, int rhi, int c0, int lane) {
    const int g = lane >> 4, q = (lane & 15) >> 2, p = lane & 3;
    const s16x4 lo = tr4(img + (rlo + 4 * g + q) * stride + (c0 + 4 * p) * 2), hi = tr4(img + (rhi + 4 * g + q) * stride + (c0 + 4 * p) * 2);
    return (bf16x8){lo[0], lo[1], lo[2], lo[3], hi[0], hi[1], hi[2], hi[3]};
}
__device__ __forceinline__ bf16x8 frag_tr(LAS const unsigned char* img, int stride, int k0, int c0, int lane) {
    const int g = lane >> 4, q = (lane & 15) >> 2, p = lane & 3;
    LAS const unsigned char* a = img + (k0 + 8 * g + q) * stride + (c0 + 4 * p) * 2;
    const s16x4 lo = tr4(a), hi = tr4(a + 4 * stride);
    return (bf16x8){lo[0], lo[1], lo[2], lo[3], hi[0], hi[1], hi[2], hi[3]};
}
__device__ __forceinline__ bf16x8 pack_frag(const f32x4& a, const f32x4& b) { u32x4 w; w.x = pk2(a[0], a[1]); w.y = pk2(a[2], a[3]); w.z = pk2(b[0], b[1]); w.w = pk2(b[2], b[3]); return __builtin_bit_cast(bf16x8, w); }
#define MFMA16(a, b, c) __builtin_amdgcn_mfma_f32_16x16x32_bf16((a), (b), (c), 0, 0, 0)

__device__ __forceinline__ void transpose_item(const float* W, int K, int Nsrc, int Ndst, bf16* WT, const float* gs, int mode, LAS float* scr, int item, int lane) {
    const int nblk = Ndst / 32, kb = item / nblk, nb = item % nblk, k0 = 64 * kb, n0d = 32 * nb;
    int n0s = n0d;
    if (mode == 1) { const int gi = nb & 7, bj = gi >> 2, wc = gi & 3; n0s = (nb >> 3) * 256 + 32 * (wc * 2 + bj); }
    else if (mode == 2) { const int gi = nb & 7, bj = gi >> 2, r = gi & 3; n0s = bj * DFF + (nb >> 3) * 128 + 32 * r; }
    const int ns = n0s + (lane & 31); const bool ok = ns < Nsrc;
    float wv_[32];
#pragma unroll
    for (int i = 0; i < 32; ++i) { const int kk = 2 * i + (lane >> 5); wv_[i] = ok ? W[(size_t)(k0 + kk) * Nsrc + ns] : 0.f; }
    if (gs) {
#pragma unroll
        for (int i = 0; i < 32; ++i) wv_[i] *= gs[k0 + 2 * i + (lane >> 5)]; }
#pragma unroll
    for (int i = 0; i < 32; ++i) scr[(2 * i + (lane >> 5)) * 33 + (lane & 31)] = wv_[i];
    LDS_WAIT();
    const int c = lane & 7;
#pragma unroll
    for (int j = 0; j < 4; ++j) { const int n = (lane >> 3) + 8 * j; const LAS float* s = scr + (8 * c) * 33 + n;
        u32x4 o; o.x = pk2(s[0 * 33], s[1 * 33]); o.y = pk2(s[2 * 33], s[3 * 33]); o.z = pk2(s[4 * 33], s[5 * 33]); o.w = pk2(s[6 * 33], s[7 * 33]);
        *(u32x4*)(WT + (size_t)(n0d + n) * K + k0 + 8 * c) = o; }
    LDS_WAIT();
}

__device__ __forceinline__ void prologue(const Params& p, LAS unsigned char* lds, int gw, int NGW, int gtid, int NT, int wave, int lane) {
    LAS float* scr = (LAS float*)(lds + wave * WAVE_LDS);
    unsigned char* ws = p.ws;
    constexpr int I_IN = 16 * (N_IN / 32), I_QKV = 16 * (N_QKV / 32), I_FFI = 16 * (N_FF2 / 32), I_FFO = (DFF / 64) * 32, I_SQ = 16 * 32;
    constexpr int NITEMS = 2 * I_IN + 2 * I_QKV + 4 * I_FFI + 4 * I_FFO + 2 * I_SQ + 2 * I_SQ;
    for (int it = gw; it < NITEMS; it += NGW) {
        int r = it;
        if (r < 2 * I_IN) { const int e = r / I_IN; r -= e * I_IN; transpose_item(p.in[8] + (size_t)e * 1024 * N_IN_SRC, 1024, N_IN_SRC, N_IN, (bf16*)(ws + W_IN) + (size_t)e * N_IN * 1024, p.in[6] + (2 * e) * 1024, 0, scr, r, lane); continue; } r -= 2 * I_IN;
        if (r < 2 * I_QKV) { const int o = r / I_QKV; r -= o * I_QKV; transpose_item(p.in[14] + (size_t)o * 1024 * N_QKV, 1024, N_QKV, N_QKV, (bf16*)(ws + W_QKV) + (size_t)o * N_QKV * 1024, p.in[6] + (2 * o + 1) * 1024, 1, scr, r, lane); continue; } r -= 2 * I_QKV;
        if (r < 4 * I_FFI) { const int l = r / I_FFI; r -= l * I_FFI; transpose_item(p.in[19] + (size_t)l * 1024 * N_FF2, 1024, N_FF2, N_FF2, (bf16*)(ws + W_FFI) + (size_t)l * N_FF2 * 1024, p.in[7] + l * 1024, 2, scr, r, lane); continue; } r -= 4 * I_FFI;
        if (r < 4 * I_FFO) { const int l = r / I_FFO; r -= l * I_FFO; transpose_item(p.in[20] + (size_t)l * DFF * 1024, DFF, 1024, 1024, (bf16*)(ws + W_FFO) + (size_t)l * 1024 * DFF, nullptr, 0, scr, r, lane); continue; } r -= 4 * I_FFO;
        if (r < 2 * I_SQ) { const int e = r / I_SQ; r -= e * I_SQ; transpose_item(p.in[13] + (size_t)e * 1024 * 1024, 1024, 1024, 1024, (bf16*)(ws + W_OUT) + (size_t)e * 1024 * 1024, nullptr, 0, scr, r, lane); continue; } r -= 2 * I_SQ;
        { const int o = r / I_SQ; r -= o * I_SQ; transpose_item(p.in[18] + (size_t)o * 1024 * 1024, 1024, 1024, 1024, (bf16*)(ws + W_O) + (size_t)o * 1024 * 1024, nullptr, 0, scr, r, lane); }
    }
    float* ssq = (float*)(ws + W_SSQ); bf16* xb = (bf16*)(ws + W_XB);
    for (int m = gw; m < TT; m += NGW) {
        const float* src = (m < TP) ? p.in[0] + (size_t)m * DM : p.in[1] + (size_t)(m - TP) * DM;
        const f32x4* s4 = (const f32x4*)src + lane; f32x4 v[4]; float ss = 0.f;
#pragma unroll
        for (int j = 0; j < 4; ++j) { v[j] = s4[64 * j]; ss += (v[j][0] * v[j][0] + v[j][1] * v[j][1]) + (v[j][2] * v[j][2] + v[j][3] * v[j][3]); }
        ss = wave_sum(ss);
        u32x2* b2 = (u32x2*)(xb + (size_t)m * DM) + lane;
#pragma unroll
        for (int j = 0; j < 4; ++j) { u32x2 w; w.x = pk2(v[j][0], v[j][1]); w.y = pk2(v[j][2], v[j][3]); b2[64 * j] = w; }
        if (lane < 16) ssq[(size_t)m * 16 + lane] = (lane == 0) ? ss : 0.f;
    }
    constexpr int PER = 448 * 256, NCP = 2 * 8 * PER;
    for (int i0 = gtid; i0 < 2 * NCP; i0 += 4 * NT) { f32x4 v[4];
#pragma unroll
        for (int q = 0; q < 4; ++q) { const int i = i0 + q * NT; if (i < 2 * NCP) { const int t = i / NCP, j = i % NCP, ob = j / PER, rem = j % PER; v[q] = *((const f32x4*)(p.in[4 + t] + ((size_t)ob * 512 + 64) * 1024) + rem); } }
#pragma unroll
        for (int q = 0; q < 4; ++q) { const int i = i0 + q * NT; if (i < 2 * NCP) { const int t = i / NCP, j = i % NCP, ob = j / PER, rem = j % PER; *((f32x4*)(p.out + (t ? O_VS : O_KS) + (size_t)ob * 512 * 1024) + rem) = v[q]; } } }
}

__device__ __forceinline__ void unpack8(const u32x4& w, float* f) { f[0] = bflo(w.x); f[1] = bfhi(w.x); f[2] = bflo(w.y); f[3] = bfhi(w.y); f[4] = bflo(w.z); f[5] = bfhi(w.z); f[6] = bflo(w.w); f[7] = bfhi(w.w); }
__device__ __forceinline__ void conv_u(const bf16* proj, int row, int c, float* u) {
    float a[8], b[8]; unpack8(*(const u32x4*)(proj + (size_t)row * N_IN + C_CG + c), a); unpack8(*(const u32x4*)(proj + (size_t)row * N_IN + C_HC + c), b);
#pragma unroll
    for (int k = 0; k < 8; ++k) u[k] = a[k] * b[k];
}
__device__ __forceinline__ void conv_phase(const Params& p, int e, int gtid, int NT) {
    const bf16* proj = (const bf16*)(p.ws + W_PROJ); bf16* mix = (bf16*)(p.ws + W_MIX);
    const float* cw = p.in[9] + e * 3 * 512;
    for (int idx = gtid; idx < TT * 64; idx += NT) {
        const int row = idx >> 6, c = (idx & 63) * 8;
        int b, t, T; const float* prev = nullptr; float* st;
        if (row < TP) { b = row >> 12; t = row & 4095; T = 4096; st = p.out + O_CONVP + (size_t)((e * 4 + b) * 2) * 512; }
        else { const int rs = row - TP; b = rs >> 6; t = rs & 63; T = 64; prev = p.in[2] + (size_t)((e * 8 + b) * 2) * 512; st = p.out + O_CONVS + (size_t)((e * 8 + b) * 2) * 512; }
        float u2[8], u1[8], u0[8];
        conv_u(proj, row, c, u2);
        if (t >= 1) conv_u(proj, row - 1, c, u1); else {
#pragma unroll
            for (int k = 0; k < 8; ++k) u1[k] = prev ? prev[512 + c + k] : 0.f; }
        if (t >= 2) conv_u(proj, row - 2, c, u0); else {
#pragma unroll
            for (int k = 0; k < 8; ++k) u0[k] = prev ? prev[t * 512 + c + k] : 0.f; }
        float bg[8]; unpack8(*(const u32x4*)(proj + (size_t)row * N_IN + C_BG + c), bg);
        float y[8];
#pragma unroll
        for (int k = 0; k < 8; ++k) y[k] = bg[k] * (cw[c + k] * u0[k] + cw[512 + c + k] * u1[k] + cw[1024 + c + k] * u2[k]);
        u32x4 w; w.x = pk2(y[0], y[1]); w.y = pk2(y[2], y[3]); w.z = pk2(y[4], y[5]); w.w = pk2(y[6], y[7]);
        *(u32x4*)(mix + (size_t)row * DM + c) = w;
        if (t >= T - 2) { float* d = st + (t - (T - 2)) * 512 + c; *(f32x4*)d = (f32x4){u2[0], u2[1], u2[2], u2[3]}; *(f32x4*)(d + 4) = (f32x4){u2[4], u2[5], u2[6], u2[7]}; }
    }
}

__device__ __forceinline__ void gla_local(const Params& p, int e, LAS unsigned char* wl, int gw, int NGW, int lane) {
    const bf16* proj = (const bf16*)(p.ws + W_PROJ); bf16* QE = (bf16*)(p.ws + W_QE); bf16* KE = (bf16*)(p.ws + W_KE);
    float* UT = (float*)(p.ws + W_MIX); float* DEC = (float*)(p.ws + W_DEC);
    LAS unsigned char* keimg = wl; LAS unsigned char* vimg = wl + 64 * 144;
    const int g = lane >> 4;
    for (int item = gw; item < NGLA; item += NGW) {
        const int ci = item >> 2, h = item & 3, row0 = ci * 64, ch = h * 64 + lane;
        float w2c[16];
#pragma unroll
        for (int r = 0; r < 16; ++r) w2c[r] = p.in[10][(size_t)(e * 16 + r) * 256 + ch];
        const float bias = p.in[11][e * 256 + ch];
        float gl[16];
        { const bf16* gp = proj + (size_t)(row0 + lane) * N_IN + C_GK; float t8[8]; unpack8(*(const u32x4*)gp, t8);
#pragma unroll
          for (int r = 0; r < 8; ++r) gl[r] = t8[r];
          unpack8(*(const u32x4*)(gp + 8), t8);
#pragma unroll
          for (int r = 0; r < 8; ++r) gl[8 + r] = t8[r]; }
        float bc = 0.f;
#pragma unroll 1
        for (int jh = 0; jh < 2; ++jh) {
            unsigned kq[32];
#pragma unroll
            for (int jj = 0; jj < 32; ++jj) { const bf16* rp = proj + (size_t)(row0 + jh * 32 + jj) * N_IN + ch; kq[jj] = (unsigned)rp[C_Q] | ((unsigned)rp[C_K] << 16); }
#pragma unroll
            for (int jj = 0; jj < 32; ++jj) {
                const int j = jh * 32 + jj;
                float z = bias;
#pragma unroll
                for (int r = 0; r < 16; ++r) z += __builtin_bit_cast(float, __builtin_amdgcn_readlane(__builtin_bit_cast(int, gl[r]), j)) * w2c[r];
                const float la = (fminf(z, 0.f) - log1pf(__expf(-fabsf(z)))) * (1.0f / 16.0f);
                bc += la;
                const float qv = bflo(kq[jj]) * 0.125f * __expf(bc), kv = bfhi(kq[jj]) * __expf(-bc);
                const unsigned short qb = f2bf(qv), kb = f2bf(kv);
                QE[(size_t)(row0 + j) * 256 + ch] = qb; KE[(size_t)(row0 + j) * 256 + ch] = kb;
                *(LAS unsigned short*)(keimg + j * 144 + lane * 2) = kb;
            }
        }
        DEC[ci * 256 + ch] = __expf(bc);
#pragma unroll 1
        for (int vh = 0; vh < 2; ++vh) {
#pragma unroll
            for (int it = 0; it < 8; ++it) { const int j = it * 8 + (lane >> 3), seg = lane & 7;
                *(LAS u32x4*)(vimg + j * 144 + seg * 16) = *(const u32x4*)(proj + (size_t)(row0 + j) * N_IN + C_V + h * 128 + vh * 64 + seg * 8); }
            CBAR();
            f32x4 acc[4][4];
#pragma unroll
            for (int a = 0; a < 4; ++a)
#pragma unroll
                for (int b = 0; b < 4; ++b) acc[a][b] = (f32x4){0.f, 0.f, 0.f, 0.f};
#pragma unroll
            for (int ks = 0; ks < 2; ++ks) {
                bf16x8 A[4], B[4];
#pragma unroll
                for (int a = 0; a < 4; ++a) { A[a] = frag_tr(vimg, 144, 32 * ks, 16 * a, lane); B[a] = frag_tr(keimg, 144, 32 * ks, 16 * a, lane); }
#pragma unroll
                for (int a = 0; a < 4; ++a)
#pragma unroll
                    for (int b = 0; b < 4; ++b) acc[a][b] = MFMA16(A[a], B[b], acc[a][b]);
            }
            float* ut = UT + (size_t)item * 8192 + (size_t)(vh * 64 + 4 * g) * 64 + (lane & 15);
#pragma unroll
            for (int a = 0; a < 4; ++a)
#pragma unroll
                for (int b = 0; b < 4; ++b)
#pragma unroll
                    for (int r = 0; r < 4; ++r) ut[(16 * a + r) * 64 + 16 * b] = acc[a][b][r];
            CBAR();
        }
    }
}

__device__ __forceinline__ void gla_scan(const Params& p, int e, int gtid, int NT) {
    const float* UT = (const float*)(p.ws + W_MIX); const float* DEC = (const float*)(p.ws + W_DEC); bf16* ST = (bf16*)(p.ws + W_ST);
    for (int w = gtid; w < 48 * 2048; w += NT) {
        const int bh = w >> 11, rem = w & 2047, v = rem >> 4, dq = rem & 15;
        if (bh < 16) { const int b = bh >> 2, h = bh & 3; f32x4 S = (f32x4){0.f, 0.f, 0.f, 0.f};
            for (int c0 = 0; c0 < 64; c0 += 16) { f32x4 U[16], Dd[16];
#pragma unroll
                for (int s = 0; s < 16; ++s) { const int ci = b * 64 + c0 + s, item = ci * 4 + h; U[s] = *(const f32x4*)(UT + (size_t)item * 8192 + v * 64 + 4 * dq); Dd[s] = *(const f32x4*)(DEC + ci * 256 + h * 64 + 4 * dq); }
#pragma unroll
                for (int s = 0; s < 16; ++s) { const int item = (b * 64 + c0 + s) * 4 + h; u32x2 wv; wv.x = pk2(S[0], S[1]); wv.y = pk2(S[2], S[3]); *(u32x2*)(ST + (size_t)item * 8192 + v * 64 + 4 * dq) = wv; S = Dd[s] * (S + U[s]); } }
            float* o = p.out + O_GLAP + (size_t)((e * 4 + b) * 4 + h) * 8192 + (size_t)(4 * dq) * 128 + v;
#pragma unroll
            for (int k = 0; k < 4; ++k) o[k * 128] = S[k];
        } else { const int bs = bh - 16, b = bs >> 2, h = bs & 3, ci = 256 + b, item = ci * 4 + h;
            const float* s0 = p.in[3] + (size_t)((e * 8 + b) * 4 + h) * 8192 + (size_t)(4 * dq) * 128 + v;
            f32x4 S; S[0] = s0[0]; S[1] = s0[128]; S[2] = s0[256]; S[3] = s0[384];
            u32x2 wv; wv.x = pk2(S[0], S[1]); wv.y = pk2(S[2], S[3]); *(u32x2*)(ST + (size_t)item * 8192 + v * 64 + 4 * dq) = wv;
            const f32x4 U = *(const f32x4*)(UT + (size_t)item * 8192 + v * 64 + 4 * dq), Dd = *(const f32x4*)(DEC + ci * 256 + h * 64 + 4 * dq);
            S = Dd * (S + U);
            float* o = p.out + O_GLAS + (size_t)((e * 8 + b) * 4 + h) * 8192 + (size_t)(4 * dq) * 128 + v;
#pragma unroll
            for (int k = 0; k < 4; ++k) o[k * 128] = S[k];
        }
    }
}

__device__ __forceinline__ void gla_out(const Params& p, int e, LAS unsigned char* vimg, int gw, int NGW, int lane) {
    const bf16* proj = (const bf16*)(p.ws + W_PROJ); const bf16* QE = (const bf16*)(p.ws + W_QE); const bf16* KE = (const bf16*)(p.ws + W_KE); const bf16* ST = (const bf16*)(p.ws + W_ST);
    bf16* mix = (bf16*)(p.ws + W_MIX); const float* onorm = p.in[12] + e * 128;
    const int g = lane >> 4, l15 = lane & 15;
    for (int item = gw; item < NGLA; item += NGW) {
        const int ci = item >> 2, h = item & 3, row0 = ci * 64;
        CBAR();
#pragma unroll
        for (int it = 0; it < 16; ++it) { const int j = it * 4 + (lane >> 4), seg = lane & 15;
            *(LAS u32x4*)(vimg + j * 272 + seg * 16) = *(const u32x4*)(proj + (size_t)(row0 + j) * N_IN + C_V + h * 128 + seg * 8); }
        CBAR();
        const bf16* STi = ST + (size_t)item * 8192; const bf16* QEr = QE + (size_t)row0 * 256 + h * 64; const bf16* KEr = KE + (size_t)row0 * 256 + h * 64;
#pragma unroll 1
        for (int ih = 0; ih < 2; ++ih) {
            bf16x8 Bq[2][2];
#pragma unroll
            for (int ib = 0; ib < 2; ++ib)
#pragma unroll
                for (int ks = 0; ks < 2; ++ks) Bq[ib][ks] = *(const bf16x8*)(QEr + (size_t)(32 * ih + 16 * ib + l15) * 256 + 32 * ks + 8 * g);
            f32x4 att[4][2];
#pragma unroll
            for (int jb = 0; jb < 4; ++jb) {
                bf16x8 Ak[2];
#pragma unroll
                for (int ks = 0; ks < 2; ++ks) Ak[ks] = *(const bf16x8*)(KEr + (size_t)(16 * jb + l15) * 256 + 32 * ks + 8 * g);
#pragma unroll
                for (int ib = 0; ib < 2; ++ib) { f32x4 a = (f32x4){0.f, 0.f, 0.f, 0.f}; a = MFMA16(Ak[0], Bq[ib][0], a); a = MFMA16(Ak[1], Bq[ib][1], a);
                    const int i = 32 * ih + 16 * ib + l15, j0 = 16 * jb + 4 * g;
#pragma unroll
                    for (int r = 0; r < 4; ++r) if (j0 + r > i) a[r] = 0.f;
                    att[jb][ib] = a; }
            }
            bf16x8 Bp[2][2];
#pragma unroll
            for (int ib = 0; ib < 2; ++ib)
#pragma unroll
                for (int kk = 0; kk < 2; ++kk) Bp[ib][kk] = pack_frag(att[2 * kk][ib], att[2 * kk + 1][ib]);
            f32x4 o[8][2];
#pragma unroll
            for (int vb = 0; vb < 8; ++vb) {
                o[vb][0] = (f32x4){0.f, 0.f, 0.f, 0.f}; o[vb][1] = (f32x4){0.f, 0.f, 0.f, 0.f};
#pragma unroll
                for (int kk = 0; kk < 2; ++kk) { const bf16x8 A = frag_tr2(vimg, 272, 32 * kk, 32 * kk + 16, 16 * vb, lane); o[vb][0] = MFMA16(A, Bp[0][kk], o[vb][0]); o[vb][1] = MFMA16(A, Bp[1][kk], o[vb][1]); }
#pragma unroll
                for (int ks = 0; ks < 2; ++ks) { const bf16x8 A = *(const bf16x8*)(STi + (size_t)(16 * vb + l15) * 64 + 32 * ks + 8 * g); o[vb][0] = MFMA16(A, Bq[0][ks], o[vb][0]); o[vb][1] = MFMA16(A, Bq[1][ks], o[vb][1]); }
            }
#pragma unroll
            for (int ib = 0; ib < 2; ++ib) {
                float ss = 0.f;
#pragma unroll
                for (int vb = 0; vb < 8; ++vb) { const f32x4 x = o[vb][ib]; ss += (x[0] * x[0] + x[1] * x[1]) + (x[2] * x[2] + x[3] * x[3]); }
                ss += __shfl_xor(ss, 16); ss += __shfl_xor(ss, 32);
                const float rn = rsqrtf(ss * (1.0f / 128.0f) + 1e-6f);
                const int row = row0 + 32 * ih + 16 * ib + l15;
#pragma unroll
                for (int vb = 0; vb < 8; ++vb) { const int vv = 16 * vb + 4 * g; const f32x4 wn = *(const f32x4*)(onorm + vv);
                    const u32x2 gw2 = *(const u32x2*)(proj + (size_t)row * N_IN + C_G + h * 128 + vv);
                    const float g0 = bflo(gw2.x), g1 = bfhi(gw2.x), g2 = bflo(gw2.y), g3 = bfhi(gw2.y); const f32x4 x = o[vb][ib];
                    u32x2 w; w.x = pk2(x[0] * rn * wn[0] * silu_f(g0), x[1] * rn * wn[1] * silu_f(g1)); w.y = pk2(x[2] * rn * wn[2] * silu_f(g2), x[3] * rn * wn[3] * silu_f(g3));
                    *(u32x2*)(mix + (size_t)row * DM + 512 + h * 128 + vv) = w; }
            }
        }
    }
}

__device__ __forceinline__ void kv_src(const bf16* qkv, const bf16* ckb, int ci, int h, int m, const bf16*& kb, const bf16*& vb, int& pitch) {
    if (ci >= 256 && m > 0) { kb = ckb + ((size_t)(ci - 256) * 512 + (8 - m) * 64) * 1024 + h * 64; vb = kb + (size_t)8 * 512 * 1024; pitch = 1024; }
    else { kb = qkv + (size_t)(ci * 64 - 64 * m) * N_QKV + 1024 + h * 64; vb = kb + 1024; pitch = N_QKV; }
}
__device__ __forceinline__ void attn_item(const Params& p, int o, LAS unsigned char* vimg, LAS float* tbl, int item, float qkb, int lane) {
    const bf16* qkv = (const bf16*)(p.ws + W_PROJ); const bf16* ckb = (const bf16*)(p.ws + W_ST); bf16* mix = (bf16*)(p.ws + W_MIX);
    const int g = lane >> 4, l15 = lane & 15;
    constexpr float LOG2E = 1.4426950408889634f, C1 = 0.125f * LOG2E;
    const int ci = item >> 5, h = (item >> 1) & 15, ih = item & 1, row0 = ci * 64;
    const int nprev = ci >= 256 ? 8 : ((ci & 63) < 8 ? (ci & 63) : 8);
    CBAR();
    { const float* rb = p.in[17] + (size_t)(o * 16 + h) * 320; float bv[5]; float bm = -1e30f;
#pragma unroll
      for (int t = 0; t < 5; ++t) { bv[t] = rb[lane + 64 * t]; bm = fmaxf(bm, bv[t]); }
#pragma unroll
      for (int s = 1; s < 64; s <<= 1) bm = fmaxf(bm, __shfl_xor(bm, s));
      const float M = qkb + bm; const float last = (__builtin_bit_cast(float, __builtin_amdgcn_readlane(__builtin_bit_cast(int, bv[4]), 63)) - M) * LOG2E;
#pragma unroll
      for (int t = 0; t < 5; ++t) tbl[lane + 64 * t] = (bv[t] - M) * LOG2E;
#pragma unroll
      for (int t = 5; t < 10; ++t) tbl[lane + 64 * t] = last; }
    bf16x8 Bq[2][2];
#pragma unroll
    for (int ib = 0; ib < 2; ++ib)
#pragma unroll
        for (int ks = 0; ks < 2; ++ks) Bq[ib][ks] = *(const bf16x8*)(qkv + (size_t)(row0 + 32 * ih + 16 * ib + l15) * N_QKV + h * 64 + 32 * ks + 8 * g);
    f32x4 O[4][2]; float rsum[2] = {0.f, 0.f};
#pragma unroll
    for (int a = 0; a < 2; ++a)
#pragma unroll
        for (int b = 0; b < 4; ++b) O[b][a] = (f32x4){0.f, 0.f, 0.f, 0.f};
    bf16x8 Kn[4][2]; u32x4 Vn[8];
    const int vkey = lane >> 3, vseg = lane & 7;
    { const bf16* kb; const bf16* vb; int pitch; kv_src(qkv, ckb, ci, h, nprev, kb, vb, pitch);
#pragma unroll
      for (int it = 0; it < 8; ++it) Vn[it] = *(const u32x4*)(vb + (size_t)(it * 8 + vkey) * pitch + vseg * 8);
#pragma unroll
      for (int jb = 0; jb < 4; ++jb)
#pragma unroll
          for (int ks = 0; ks < 2; ++ks) Kn[jb][ks] = *(const bf16x8*)(kb + (size_t)(16 * jb + l15) * pitch + 32 * ks + 8 * g); }
#pragma unroll 1
    for (int m = nprev; m >= 0; --m) {
        bf16x8 Ak[4][2];
        CBAR();
#pragma unroll
        for (int it = 0; it < 8; ++it) *(LAS u32x4*)(vimg + (it * 8 + vkey) * 144 + vseg * 16) = Vn[it];
#pragma unroll
        for (int jb = 0; jb < 4; ++jb)
#pragma unroll
            for (int ks = 0; ks < 2; ++ks) Ak[jb][ks] = Kn[jb][ks];
        if (m > 0) { const bf16* kb; const bf16* vb; int pitch; kv_src(qkv, ckb, ci, h, m - 1, kb, vb, pitch);
#pragma unroll
            for (int it = 0; it < 8; ++it) Vn[it] = *(const u32x4*)(vb + (size_t)(it * 8 + vkey) * pitch + vseg * 8);
#pragma unroll
            for (int jb = 0; jb < 4; ++jb)
#pragma unroll
                for (int ks = 0; ks < 2; ++ks) Kn[jb][ks] = *(const bf16x8*)(kb + (size_t)(16 * jb + l15) * pitch + 32 * ks + 8 * g); }
        CBAR();
        const LAS float* tb = tbl + (64 * m + 32 * ih + l15 - 4 * g + 63 - 51);
        f32x4 s[4][2];
#pragma unroll
        for (int jb = 0; jb < 4; ++jb)
#pragma unroll
            for (int ib = 0; ib < 2; ++ib) { f32x4 a = (f32x4){0.f, 0.f, 0.f, 0.f}; a = MFMA16(Ak[jb][0], Bq[ib][0], a); a = MFMA16(Ak[jb][1], Bq[ib][1], a); s[jb][ib] = a; }
#pragma unroll
        for (int ib = 0; ib < 2; ++ib)
#pragma unroll
            for (int jb = 0; jb < 4; ++jb)
#pragma unroll
                for (int r = 0; r < 4; ++r) { const float pv = __builtin_amdgcn_exp2f(s[jb][ib][r] * C1 + tb[16 * ib - 16 * jb - r + 51]); s[jb][ib][r] = pv; rsum[ib] += pv; }
        bf16x8 Bp[2][2];
#pragma unroll
        for (int ib = 0; ib < 2; ++ib)
#pragma unroll
            for (int kk = 0; kk < 2; ++kk) Bp[ib][kk] = pack_frag(s[2 * kk][ib], s[2 * kk + 1][ib]);
#pragma unroll
        for (int db = 0; db < 4; ++db)
#pragma unroll
            for (int kk = 0; kk < 2; ++kk) { const bf16x8 A = frag_tr2(vimg, 144, 32 * kk, 32 * kk + 16, 16 * db, lane);
                O[db][0] = MFMA16(A, Bp[0][kk], O[db][0]); O[db][1] = MFMA16(A, Bp[1][kk], O[db][1]); }
    }
#pragma unroll
    for (int I = 0; I < 2; ++I) { float rs = rsum[I]; rs += __shfl_xor(rs, 16); rs += __shfl_xor(rs, 32); const float il = 1.0f / rs; const int row = row0 + 32 * ih + 16 * I + l15;
#pragma unroll
        for (int db = 0; db < 4; ++db) { const f32x4 x = O[db][I] * il; u32x2 w; w.x = pk2(x[0], x[1]); w.y = pk2(x[2], x[3]); *(u32x2*)(mix + (size_t)row * DM + h * 64 + 16 * db + 4 * g) = w; } }
}
__device__ __forceinline__ void cache_to_bf16(const Params& p, int o, int gtid, int NT) {
    constexpr int N8 = 8 * 512 * 1024 / 8;
    bf16* dst = (bf16*)(p.ws + W_ST);
    for (int i = gtid; i < 2 * N8; i += NT) { const int t = i / N8, j = i % N8; const float* s = p.in[4 + t] + (size_t)o * 8 * 512 * 1024 + (size_t)j * 8;
        const f32x4 a = *(const f32x4*)s, b = *(const f32x4*)(s + 4); u32x4 w; w.x = pk2(a[0], a[1]); w.y = pk2(a[2], a[3]); w.z = pk2(b[0], b[1]); w.w = pk2(b[2], b[3]);
        *(u32x4*)(dst + (size_t)t * 8 * 512 * 1024 + (size_t)j * 8) = w; }
}
__device__ __forceinline__ void attn_phase(const Params& p, int o, LAS unsigned char* wl, int gw, int NGW, int lane) {
    LAS unsigned char* vimg = wl; LAS float* tbl = (LAS float*)(wl + 64 * 144);
    float wmax = fabsf(p.in[15][o * 64 + lane]), kmax = fabsf(p.in[16][o * 64 + lane]);
#pragma unroll
    for (int s = 1; s < 64; s <<= 1) { wmax = fmaxf(wmax, __shfl_xor(wmax, s)); kmax = fmaxf(kmax, __shfl_xor(kmax, s)); }
    const float qkb = 8.0f * wmax * kmax;
    const int G = NGW >> 3, b = gw >> 3, w = gw & 7;
    const int x = b & 7, lw = (b >> 3) * 8 + w, nlw = ((G - x + 7) >> 3) * 8;
#pragma unroll 1
    for (int t = lw; t < NCHUNK * 4; t += nlw) {
        const int cidx = t >> 2, ci = cidx < 8 ? 256 + cidx : cidx - 8, item = (ci << 5) | ((2 * x + ((t >> 1) & 1)) << 1) | (t & 1);
        attn_item(p, o, vimg, tbl, item, qkb, lane);
    }
}

#define XB_TMO      128
#define XB_XCNT(j)  (256  + 64 * (j))
#define XB_XSUB(j)  (1280 + 64 * (j))
#define XB_XGEN(j)  (2304 + 64 * (j))
#define XB_TOP      3328
#define XB_TOPGEN   3392
#define XCD_BAR_WORDS 3456
#define XB_SPIN_CAP (1u << 18)

__device__ __forceinline__ unsigned xb_ld(unsigned* p)              { return __hip_atomic_load(p, __ATOMIC_RELAXED, __HIP_MEMORY_SCOPE_AGENT); }
__device__ __forceinline__ unsigned xb_add(unsigned* p, unsigned v) { return __hip_atomic_fetch_add(p, v, __ATOMIC_RELAXED, __HIP_MEMORY_SCOPE_AGENT); }
__device__ __forceinline__ unsigned xb_xcc_id() { return (unsigned)__builtin_amdgcn_s_getreg((3 << 11) | 20) & 0xFu; }
#define XB_SPIN(cond, bar) do { unsigned _sp = 0; while (cond) { __builtin_amdgcn_s_sleep(1); \
    if ((++_sp & 255u) == 0u) { if (xb_ld(&(bar)[XB_TMO])) break; if (_sp > XB_SPIN_CAP) { atomicAdd(&(bar)[XB_TMO], 1u); break; } } } } while (0)

struct XcdBarrier {
    unsigned* bar; unsigned x;
    volatile LAS unsigned* st;
};

__device__ __forceinline__ XcdBarrier xcd_barrier_post(unsigned* bar, volatile LAS unsigned* st) {
    XcdBarrier b; b.bar = bar; b.x = xb_xcc_id(); b.st = st;
    if (threadIdx.x == 0) (void)xb_add(&bar[XB_XCNT(b.x)], 1u);
    return b;
}
__device__ __forceinline__ void xcd_barrier_complete(unsigned* bar, unsigned x, unsigned& nloc, unsigned& nx) {
    const unsigned G = gridDim.x * gridDim.y * gridDim.z;
    unsigned sum, cnt, mine, sp = 0u;
    for (;;) {
        sum = 0u; cnt = 0u; mine = 0u;
#pragma unroll
        for (unsigned j = 0; j < 16; ++j) { const unsigned c = xb_ld(&bar[XB_XCNT(j)]); sum += c; cnt += (c > 0u) ? 1u : 0u; mine = (j == x) ? c : mine; }
        if (sum == G) break;
        __builtin_amdgcn_s_sleep(1);
        if ((++sp & 255u) == 0u) { if (xb_ld(&bar[XB_TMO])) break; if (sp > XB_SPIN_CAP) { atomicAdd(&bar[XB_TMO], 1u); break; } }
    }
    nloc = mine > 0u ? mine : 1u; nx = cnt > 0u ? cnt : 1u;
}

__device__ __forceinline__ void xcd_barrier(const XcdBarrier& b) {
    asm volatile("s_waitcnt vmcnt(0)" ::: "memory");
    __syncthreads();
    if (threadIdx.x == 0) {
        unsigned* bar = b.bar;
        __builtin_amdgcn_s_waitcnt(0);
        unsigned nloc = b.st[0], nx = b.st[1];
        if (nloc == 0u) { xcd_barrier_complete(bar, b.x, nloc, nx); b.st[0] = nloc; b.st[1] = nx; }
        const unsigned old = xb_add(&bar[XB_XSUB(b.x)], 1u);
        const unsigned gen = old / nloc;
        if (old + 1u == (gen + 1u) * nloc) {
            __builtin_amdgcn_fence(__ATOMIC_RELEASE, "agent");
            asm volatile("s_waitcnt vmcnt(0)" ::: "memory");
            const unsigned og = xb_add(&bar[XB_TOP], 1u);
            const unsigned tg = og / nx;
            if (og + 1u == (tg + 1u) * nx) xb_add(&bar[XB_TOPGEN], 1u);
            else XB_SPIN(xb_ld(&bar[XB_TOPGEN]) == tg, bar);
            __builtin_amdgcn_fence(__ATOMIC_ACQUIRE, "agent");
            xb_add(&bar[XB_XGEN(b.x)], 1u);
            asm volatile("s_waitcnt vmcnt(0)" ::: "memory");
        } else {
            XB_SPIN(xb_ld(&bar[XB_XGEN(b.x)]) == gen, bar);
            __builtin_amdgcn_fence(__ATOMIC_ACQUIRE, "agent");
            asm volatile("s_waitcnt vmcnt(0)" ::: "memory");
        }
    }
    __syncthreads();
}

#ifndef MK_SPLIT
#define MK_SPLIT 0
#endif
#ifndef PHMASK
#define PHMASK 0x7ff
#endif
#if MK_SPLIT
#define GRID_SYNC() do { } while (0)
#define PH(k) if (((PHMASK >> (k)) & 1) && ph == (k))
#else
#define COOP_SYNC() do { asm volatile("s_waitcnt vmcnt(0) lgkmcnt(0)" ::: "memory"); grid.sync(); __builtin_amdgcn_fence(__ATOMIC_ACQUIRE, "agent"); asm volatile("s_waitcnt vmcnt(0)" ::: "memory"); __syncthreads(); } while (0)
#define GRID_SYNC() xcd_barrier(bar)
#ifndef DUPMASK
#define DUPMASK 0
#endif
#ifndef EXTRA_SYNCS
#define EXTRA_SYNCS 0
#endif
#define PH(k) if constexpr ((((PHMASK) >> (k)) & 1) != 0) _Pragma("unroll 1") for (int rep_ = 0; rep_ < ((((DUPMASK) >> (k)) & 1) ? 2 : 1); ++rep_)
#endif

__global__ void __launch_bounds__(512) mega_fwd(Params p, int ph, int layer_arg) {
    extern __shared__ __attribute__((aligned(16))) unsigned char lds_raw[];
    LAS unsigned char* lds = (LAS unsigned char*)lds_raw;
#if !MK_SPLIT
    cg::grid_group grid = cg::this_grid();
#endif
    const int tid = threadIdx.x, lane = tid & 63, wave = __builtin_amdgcn_readfirstlane(tid >> 6), G = gridDim.x;
    const int gw = blockIdx.x * 8 + wave, NGW = G * 8, gtid = blockIdx.x * 512 + tid, NT = G * 512;
    LAS unsigned char* wl = lds + wave * WAVE_LDS;
    if (tid < 16) ((LAS unsigned*)(lds + LDS_CTL))[tid] = 0u;
    __syncthreads();
    XcdBarrier bar = xcd_barrier_post((unsigned*)(p.ws + W_BAR), (volatile LAS unsigned*)(lds + LDS_CTL));
    unsigned char* ws = p.ws;
    float* ssq = (float*)(ws + W_SSQ); bf16* xb = (bf16*)(ws + W_XB); bf16* proj = (bf16*)(ws + W_PROJ); bf16* mix = (bf16*)(ws + W_MIX);

#pragma unroll 1
    for (int xs_ = 0; xs_ < EXTRA_SYNCS; ++xs_) GRID_SYNC();
    PH(0) { prologue(p, lds, gw, NGW, OPQ((int)blockIdx.x * 512 + wave * 64 + LANE_NOW()), NT, wave, OPQ(LANE_NOW())); COOP_SYNC(); }
#if MK_SPLIT
    const int l_lo = layer_arg, l_hi = layer_arg + 1;
#else
    const int l_lo = 0, l_hi = 4;
#endif
#pragma unroll 1
    for (int layer = l_lo; layer < l_hi; ++layer) {
        const int e = layer >> 1;
        if ((layer & 1) == 0) {
            PH(1) { pg8::Gemm gm{xb, (const bf16*)(ws + W_IN) + (size_t)e * N_IN * 1024, TT, N_IN, 1024}; pg8::StaticOrder S; S.init(TT, N_IN, G, (int)blockIdx.x);
                pg8::EpiRowScale E{proj, N_IN, ssq + (size_t)(2 * layer) * TT * 16};
                pg8::gemm_phase<pg8::EpiRowScale, pg8::StaticOrder, true, true>(lds, gm, S, E); GRID_SYNC(); }
            PH(2) { gla_local(p, e, wl, gw, NGW, OPQ(LANE_NOW())); GRID_SYNC(); }
            PH(3) { gla_scan(p, e, OPQ((int)blockIdx.x * 512 + wave * 64 + LANE_NOW()), NT); GRID_SYNC(); }
            PH(4) { conv_phase(p, e, OPQ((int)blockIdx.x * 512 + wave * 64 + LANE_NOW()), NT); gla_out(p, e, wl, gw, NGW, OPQ(LANE_NOW())); GRID_SYNC(); }
            PH(5) { pg8::Gemm gm{mix, (const bf16*)(ws + W_OUT) + (size_t)e * 1024 * 1024, TT, 1024, 1024}; pg8::StaticOrder S; S.init(TT, 1024, G, (int)blockIdx.x);
                pg8::EpiResid E{nullptr, xb, ssq + (size_t)(2 * layer + 1) * TT * 16};
                pg8::gemm_phase<pg8::EpiResid, pg8::StaticOrder, true, true>(lds, gm, S, E); GRID_SYNC(); }
        } else {
            PH(6) { cache_to_bf16(p, e, OPQ((int)blockIdx.x * 512 + wave * 64 + LANE_NOW()), NT);
                pg8::Gemm gm{xb, (const bf16*)(ws + W_QKV) + (size_t)e * N_QKV * 1024, TT, N_QKV, 1024}; pg8::StaticOrder S; S.init(TT, N_QKV, G, (int)blockIdx.x);
                pg8::EpiQKV E{proj, ssq + (size_t)(2 * layer) * TT * 16, p.in[15] + e * 64, p.in[16] + e * 64,
                              p.out + O_KP + (size_t)e * 4 * 512 * 1024, p.out + O_VP + (size_t)e * 4 * 512 * 1024, p.out + O_KS + (size_t)e * 8 * 512 * 1024, p.out + O_VS + (size_t)e * 8 * 512 * 1024};
                pg8::gemm_phase<pg8::EpiQKV, pg8::StaticOrder, true, true>(lds, gm, S, E); GRID_SYNC(); }
            PH(7) { attn_phase(p, e, wl, gw, NGW, OPQ(LANE_NOW())); GRID_SYNC(); }
            PH(8) { pg8::Gemm gm{mix, (const bf16*)(ws + W_O) + (size_t)e * 1024 * 1024, TT, 1024, 1024}; pg8::StaticOrder S; S.init(TT, 1024, G, (int)blockIdx.x);
                pg8::EpiResid E{nullptr, xb, ssq + (size_t)(2 * layer + 1) * TT * 16};
                pg8::gemm_phase<pg8::EpiResid, pg8::StaticOrder, true, true>(lds, gm, S, E); GRID_SYNC(); }
        }
        PH(9) { pg8::Gemm gm{xb, (const bf16*)(ws + W_FFI) + (size_t)layer * N_FF2 * 1024, TT, N_FF2, 1024}; pg8::StaticOrder S; S.init(TT, N_FF2, G, (int)blockIdx.x);
            pg8::EpiSwiGLU E{proj, ssq + (size_t)(2 * layer + 1) * TT * 16};
            pg8::gemm_phase<pg8::EpiSwiGLU, pg8::StaticOrder, true, true>(lds, gm, S, E); GRID_SYNC(); }
        PH(10) { pg8::Gemm gm{proj, (const bf16*)(ws + W_FFO) + (size_t)layer * 1024 * DFF, TT, 1024, DFF}; pg8::StaticOrder S; S.init(TT, 1024, G, (int)blockIdx.x);
            pg8::EpiResid E{layer == 3 ? p.out : nullptr, xb, ssq + (size_t)(2 * layer + 2) * TT * 16};
            pg8::gemm_phase<pg8::EpiResid, pg8::StaticOrder, true, true>(lds, gm, S, E);
            if (layer < 3) GRID_SYNC(); }
    }
}

extern "C" void kernel_launch(void* const* d_in, const int* in_sizes, int n_in, void* d_out, int out_size, void* d_ws, size_t ws_size, hipStream_t stream) {
    static int grid = 0;
    if (grid == 0) {
        if (n_in != 21 || (size_t)out_size != O_END || ws_size < W_END) { fprintf(stderr, "kernel_launch: unexpected shapes (n_in %d, out %d, ws %zu, need %zu)\n", n_in, out_size, ws_size, (size_t)W_END); grid = -1; return; }
        int dev = 0, cus = 0, per_cu = 0;
        hipGetDevice(&dev); hipDeviceGetAttribute(&cus, hipDeviceAttributeMultiprocessorCount, dev);
        if (hipFuncSetAttribute((const void*)mega_fwd, hipFuncAttributeMaxDynamicSharedMemorySize, LDS_BYTES) != hipSuccess) { fprintf(stderr, "kernel_launch: hipFuncSetAttribute failed\n"); grid = -1; return; }
        if (hipOccupancyMaxActiveBlocksPerMultiprocessor(&per_cu, (const void*)mega_fwd, 512, LDS_BYTES) != hipSuccess || per_cu < 1) { fprintf(stderr, "kernel_launch: occupancy query says %d\n", per_cu); (void)hipGetLastError(); per_cu = 1; }
        grid = cus * per_cu;
    }
    if (grid < 0) return;
    Params p{};
    for (int i = 0; i < 21; ++i) p.in[i] = (const float*)d_in[i];
    p.out = (float*)d_out; p.ws = (unsigned char*)d_ws;
#if MK_SPLIT
    hipLaunchKernelGGL(mega_fwd, dim3(grid), dim3(512), LDS_BYTES, stream, p, 0, 0);
    for (int layer = 0; layer < 4; ++layer) {
        if ((layer & 1) == 0) { for (int ph = 1; ph <= 5; ++ph) hipLaunchKernelGGL(mega_fwd, dim3(grid), dim3(512), LDS_BYTES, stream, p, ph, layer); }
        else { for (int ph = 6; ph <= 8; ++ph) hipLaunchKernelGGL(mega_fwd, dim3(grid), dim3(512), LDS_BYTES, stream, p, ph, layer); }
        for (int ph = 9; ph <= 10; ++ph) hipLaunchKernelGGL(mega_fwd, dim3(grid), dim3(512), LDS_BYTES, stream, p, ph, layer);
    }
#else
    if (hipMemsetAsync((char*)d_ws + W_BAR, 0, 16384, stream) != hipSuccess) { fprintf(stderr, "kernel_launch: memset failed\n"); return; }
    int ph = -1, la = 0;
    void* args[] = {&p, &ph, &la};
    hipError_t err = hipLaunchCooperativeKernel((const void*)mega_fwd, dim3(grid), dim3(512), args, LDS_BYTES, stream);
    if (err != hipSuccess) fprintf(stderr, "kernel_launch: cooperative launch failed: %s (grid %d)\n", hipGetErrorString(err), grid);
#endif
}
```
